# Optimizing an MI355X kernel written in HIP

```python
import math
import jax, jax.numpy as jnp
from jax import lax
import numpy as np

D_MODEL = 1024
BATCH = 8
SEQ = 2048
DEPTH = 1

MLA_HEADS = 8
MLA_QK_NOPE = 64
MLA_QK_ROPE = 32
MLA_V_DIM = 64
MLA_Q_RANK = 384
MLA_KV_RANK = 256
DIFF_HEADS = 4
DIFF_HALF = 64
DIFF_V_DIM = 2 * DIFF_HALF
MIX_WIDTH = MLA_HEADS * MLA_V_DIM + DIFF_HEADS * DIFF_V_DIM
SPLIT_SIZES = (MLA_Q_RANK, MLA_KV_RANK, MLA_QK_ROPE,
               DIFF_HEADS * DIFF_V_DIM, DIFF_HEADS * DIFF_V_DIM, DIFF_HEADS * DIFF_V_DIM)
SPLIT_POINTS = tuple(int(v) for v in np.cumsum(SPLIT_SIZES)[:-1])
IN_COLS = int(sum(SPLIT_SIZES))
N_GROUPS = 4
EXPERTS_PER_GROUP = 8
N_EXPERTS = N_GROUPS * EXPERTS_PER_GROUP
TOP_K_INNER = 2
D_FF_EXPERT = 256

ROPE_THETA = 10000.0
Q_BLOCK = 128
EPS = 1e-6

kernel_name = "hybrid_mla_diffattn_hier_moe"


def rmsnorm(x, g):
    xf = x.astype(jnp.float32)
    y = xf * lax.rsqrt(jnp.mean(xf * xf, axis=-1, keepdims=True) + EPS)
    return (y * g.astype(jnp.float32)).astype(x.dtype)


def rope(x, positions):
    half = x.shape[-1] // 2
    inv_freq = ROPE_THETA ** (-jnp.arange(half, dtype=jnp.float32) / half)
    ang = positions.astype(jnp.float32)[:, :, None, None] * inv_freq
    cos, sin = jnp.cos(ang), jnp.sin(ang)
    x1 = x[..., :half].astype(jnp.float32)
    x2 = x[..., half:].astype(jnp.float32)
    out = jnp.concatenate([x1 * cos - x2 * sin, x2 * cos + x1 * sin], axis=-1)
    return out.astype(x.dtype)


def causal_attention(q, k, v, scale):
    B, S, H, Dk = q.shape
    Dv = v.shape[-1]
    nb = S // Q_BLOCK
    qb = q.reshape(B, nb, Q_BLOCK, H, Dk).transpose(1, 0, 2, 3, 4)
    kf = k.astype(jnp.float32)
    vf = v.astype(jnp.float32)
    kpos = jnp.arange(S)

    def one_block(args):
        q_blk, i = args
        s = jnp.einsum('bqhd,bkhd->bhqk', q_blk.astype(jnp.float32), kf) * scale
        qpos = i * Q_BLOCK + jnp.arange(Q_BLOCK)
        mask = kpos[None, :] <= qpos[:, None]
        s = jnp.where(mask[None, None], s, jnp.finfo(jnp.float32).min)
        p = jax.nn.softmax(s, axis=-1)
        return jnp.einsum('bhqk,bkhd->bqhd', p, vf)

    o = lax.map(one_block, (qb, jnp.arange(nb)))
    return o.transpose(1, 0, 2, 3, 4).reshape(B, S, H, Dv).astype(v.dtype)


def hybrid_mixer(h, positions, w_in, q_norm_g, w_uq, kv_norm_g, w_ukv,
                 lam_q1, lam_k1, lam_q2, lam_k2, subln_g, w_o, lam_init):
    B, S, _ = h.shape
    proj = h @ w_in
    c_q, c_kv, k_pe, dq, dk, dv = jnp.split(proj, SPLIT_POINTS, axis=-1)

    q = (rmsnorm(c_q, q_norm_g) @ w_uq).reshape(B, S, MLA_HEADS, MLA_QK_NOPE + MLA_QK_ROPE)
    q_nope, q_pe = q[..., :MLA_QK_NOPE], q[..., MLA_QK_NOPE:]
    kv = (rmsnorm(c_kv, kv_norm_g) @ w_ukv).reshape(B, S, MLA_HEADS, MLA_QK_NOPE + MLA_V_DIM)
    k_nope, v_mla = kv[..., :MLA_QK_NOPE], kv[..., MLA_QK_NOPE:]
    k_pe = rope(k_pe[:, :, None, :], positions)
    q_m = jnp.concatenate([q_nope, rope(q_pe, positions)], axis=-1)
    k_m = jnp.concatenate([k_nope, jnp.broadcast_to(k_pe, (B, S, MLA_HEADS, MLA_QK_ROPE))], axis=-1)
    o_mla = causal_attention(q_m, k_m, v_mla, (MLA_QK_NOPE + MLA_QK_ROPE) ** -0.5)
    o_mla = o_mla.reshape(B, S, MLA_HEADS * MLA_V_DIM)

    dq = rope(dq.reshape(B, S, 2 * DIFF_HEADS, DIFF_HALF), positions).reshape(B, S, DIFF_HEADS, 2, DIFF_HALF)
    dk = rope(dk.reshape(B, S, 2 * DIFF_HEADS, DIFF_HALF), positions).reshape(B, S, DIFF_HEADS, 2, DIFF_HALF)
    dv = dv.reshape(B, S, DIFF_HEADS, DIFF_V_DIM)
    lam = (jnp.exp(jnp.sum(lam_q1.astype(jnp.float32) * lam_k1.astype(jnp.float32)))
           - jnp.exp(jnp.sum(lam_q2.astype(jnp.float32) * lam_k2.astype(jnp.float32)))
           + lam_init)
    scale_d = DIFF_HALF ** -0.5
    a1 = causal_attention(dq[..., 0, :], dk[..., 0, :], dv, scale_d).astype(jnp.float32)
    a2 = causal_attention(dq[..., 1, :], dk[..., 1, :], dv, scale_d).astype(jnp.float32)
    o_diff = rmsnorm(a1 - lam * a2, subln_g) * (1.0 - lam_init)
    o_diff = o_diff.astype(h.dtype).reshape(B, S, DIFF_HEADS * DIFF_V_DIM)

    return jnp.concatenate([o_mla, o_diff], axis=-1) @ w_o


def hier_moe(h, w_rg, b_rg, w_re, b_re, w_gate, w_up, w_down):
    B, S, D = h.shape
    t = h.reshape(B * S, D)
    g_logits = (t @ w_rg).astype(jnp.float32) + b_rg.astype(jnp.float32)
    p_group = jax.nn.softmax(g_logits, axis=-1)
    g_idx = jnp.argmax(g_logits, axis=-1)
    g_onehot = jax.nn.one_hot(g_idx, N_GROUPS, dtype=jnp.float32)
    p_g_sel = jnp.sum(p_group * g_onehot, axis=-1, keepdims=True)
    e_logits = (jnp.einsum('td,dge->tge', t, w_re).astype(jnp.float32)
                + b_re.astype(jnp.float32))
    e_logits = jnp.einsum('tge,tg->te', e_logits, g_onehot)
    p_exp = jax.nn.softmax(e_logits, axis=-1)
    top_p, top_i = lax.top_k(p_exp, TOP_K_INNER)
    top_p = top_p / jnp.sum(top_p, axis=-1, keepdims=True)
    expert_id = g_idx[:, None] * EXPERTS_PER_GROUP + top_i
    gates = jnp.einsum('tk,tkn->tn', p_g_sel * top_p,
                       jax.nn.one_hot(expert_id, N_EXPERTS, dtype=jnp.float32))
    a = jnp.einsum('td,ndf->tnf', t, w_gate)
    u = jnp.einsum('td,ndf->tnf', t, w_up)
    hdn = jax.nn.silu(a) * u * gates[:, :, None].astype(t.dtype)
    y = jnp.einsum('tnf,nfd->td', hdn, w_down)
    return y.reshape(B, S, D)


def setup_inputs(seed: int = 0) -> dict:
    key = jax.random.key(seed)
    ks = jax.random.split(key, 24)
    f32 = jnp.float32

    def nrm(k, shape, fan_in):
        return jax.random.normal(k, shape, f32) * (fan_in ** -0.5)

    def gain(k, shape):
        return 1.0 + 0.05 * jax.random.normal(k, shape, f32)

    L = DEPTH
    return {
        "x": jax.random.normal(ks[0], (BATCH, SEQ, D_MODEL), f32),
        "positions": jnp.broadcast_to(jnp.arange(SEQ, dtype=jnp.int32)[None, :], (BATCH, SEQ)),
        "attn_norm_g": gain(ks[1], (L, D_MODEL)),
        "w_in": nrm(ks[2], (L, D_MODEL, IN_COLS), D_MODEL),
        "q_norm_g": gain(ks[3], (L, MLA_Q_RANK)),
        "w_uq": nrm(ks[4], (L, MLA_Q_RANK, MLA_HEADS * (MLA_QK_NOPE + MLA_QK_ROPE)), MLA_Q_RANK),
        "kv_norm_g": gain(ks[5], (L, MLA_KV_RANK)),
        "w_ukv": nrm(ks[6], (L, MLA_KV_RANK, MLA_HEADS * (MLA_QK_NOPE + MLA_V_DIM)), MLA_KV_RANK),
        "lambda_q1": 0.1 * jax.random.normal(ks[7], (L, DIFF_HALF), f32),
        "lambda_k1": 0.1 * jax.random.normal(ks[8], (L, DIFF_HALF), f32),
        "lambda_q2": 0.1 * jax.random.normal(ks[9], (L, DIFF_HALF), f32),
        "lambda_k2": 0.1 * jax.random.normal(ks[10], (L, DIFF_HALF), f32),
        "subln_g": gain(ks[11], (L, DIFF_V_DIM)),
        "w_o": nrm(ks[12], (L, MIX_WIDTH, D_MODEL), MIX_WIDTH),
        "ffn_norm_g": gain(ks[13], (L, D_MODEL)),
        "w_router_group": nrm(ks[14], (L, D_MODEL, N_GROUPS), D_MODEL),
        "b_router_group": 0.01 * jax.random.normal(ks[15], (L, N_GROUPS), f32),
        "w_router_expert": nrm(ks[16], (L, D_MODEL, N_GROUPS, EXPERTS_PER_GROUP), D_MODEL),
        "b_router_expert": 0.01 * jax.random.normal(ks[17], (L, N_GROUPS, EXPERTS_PER_GROUP), f32),
        "w_gate": nrm(ks[18], (L, N_EXPERTS, D_MODEL, D_FF_EXPERT), D_MODEL),
        "w_up": nrm(ks[19], (L, N_EXPERTS, D_MODEL, D_FF_EXPERT), D_MODEL),
        "w_down": nrm(ks[20], (L, N_EXPERTS, D_FF_EXPERT, D_MODEL), D_FF_EXPERT),
        "final_norm_g": gain(ks[21], (D_MODEL,)),
    }


def reference(x, positions, attn_norm_g, w_in, q_norm_g, w_uq, kv_norm_g, w_ukv,
              lambda_q1, lambda_k1, lambda_q2, lambda_k2, subln_g, w_o,
              ffn_norm_g, w_router_group, b_router_group, w_router_expert, b_router_expert,
              w_gate, w_up, w_down, final_norm_g):
    h = x
    for l in range(DEPTH):
        lam_init = 0.8 - 0.6 * math.exp(-0.3 * l)
        mixed = hybrid_mixer(rmsnorm(h, attn_norm_g[l]), positions, w_in[l], q_norm_g[l], w_uq[l],
                             kv_norm_g[l], w_ukv[l], lambda_q1[l], lambda_k1[l], lambda_q2[l],
                             lambda_k2[l], subln_g[l], w_o[l], lam_init)
        h = h + mixed.astype(h.dtype)
        moe = hier_moe(rmsnorm(h, ffn_norm_g[l]), w_router_group[l], b_router_group[l],
                       w_router_expert[l], b_router_expert[l], w_gate[l], w_up[l], w_down[l])
        h = h + moe.astype(h.dtype)
    return rmsnorm(h, final_norm_g)
```

```cpp
#include <hip/hip_runtime.h>
#include <cstdio>
#include <cstdint>

#ifndef MK_N_LAUNCHES
#define MK_N_LAUNCHES 1
#endif

constexpr int NB = 8, SEQ = 2048, DM = 1024, T_TOK = NB * SEQ;
constexpr int IN_COLS = 2208, NPROJ = 2304;
constexpr int QR = 384, KVR = 256;
constexpr int NEXP = 32, DFF = 256;
constexpr int MAXPANEL = 160, MAXSLOT = MAXPANEL * 256;
constexpr float EPS = 1e-6f;
constexpr float LOG2E = 1.4426950408889634f;
constexpr float QSCALE_M = 0.10206207261596577f * LOG2E;
constexpr float QSCALE_D = 0.125f * LOG2E;
constexpr float LAM_INIT = 0.2f;

constexpr size_t MiB = 1u << 20;
constexpr size_t WS_CTL = 0, CTL_ZERO_BYTES = 1 * MiB;
constexpr size_t WS_WIN = 1 * MiB;
constexpr size_t WS_WUQ = 6 * MiB;
constexpr size_t WS_WUKV = 7 * MiB;
constexpr size_t WS_WO = 8 * MiB;
constexpr size_t WS_WGU = 10 * MiB;
constexpr size_t WS_WD = 42 * MiB;
constexpr size_t WS_CS = 58 * MiB;
constexpr size_t WS_WR = 62 * MiB;
constexpr size_t WS_REC = 62 * MiB + 256 * 1024;
constexpr size_t WS_GW = 63 * MiB;
constexpr size_t WS_PEXP = 63 * MiB + 256 * 1024;
constexpr size_t WS_XB = 64 * MiB;
constexpr size_t WS_ATT = WS_XB;
constexpr size_t WS_CQ = 96 * MiB;
constexpr size_t WS_CKV = 108 * MiB;
constexpr size_t WS_QM = 116 * MiB;
constexpr size_t WS_KM = 140 * MiB;
constexpr size_t WS_VM = 164 * MiB;
constexpr size_t WS_DQ = 180 * MiB;
constexpr size_t WS_DKI = 196 * MiB;
constexpr size_t WS_DVI = 212 * MiB;
constexpr size_t WS_TS = 96 * MiB;
constexpr size_t WS_HDN = 176 * MiB;
constexpr size_t WS_END = 228 * MiB;
constexpr int CW_TMO = 0;
constexpr int CW_BAR = 4096;
constexpr int CW_CNT = 8192;
constexpr int CW_SSQQ = 16384;
constexpr int CW_SSQKV = 32768;
static_assert((CW_SSQKV + 16384) * 4 <= (int)CTL_ZERO_BYTES, "ctl");

constexpr int RING_OFF = 0, RING_BYTES = 131072;
constexpr int LDSCTL_OFF = RING_BYTES, MISC_OFF = LDSCTL_OFF + 320;
constexpr int LDS_BYTES = 147456;

#define GAS __attribute__((address_space(1)))
#define LAS __attribute__((address_space(3)))
typedef unsigned short bf16;
typedef unsigned v4u __attribute__((ext_vector_type(4)));
typedef unsigned v2u __attribute__((ext_vector_type(2)));
typedef float f32x4 __attribute__((ext_vector_type(4)));
typedef float f32x2 __attribute__((ext_vector_type(2)));
typedef float f32x16 __attribute__((ext_vector_type(16)));
typedef short bf16x8 __attribute__((ext_vector_type(8)));
typedef short s16x4 __attribute__((ext_vector_type(4)));
typedef GAS unsigned gu32;
#define RLX_AGENT __ATOMIC_RELAXED, __HIP_MEMORY_SCOPE_AGENT
#define LDS_WAIT() asm volatile("s_waitcnt lgkmcnt(0)" ::: "memory")
#define VM_WAIT() asm volatile("s_waitcnt vmcnt(0)" ::: "memory")
__device__ __forceinline__ unsigned f2bf(float f) { unsigned u = __builtin_bit_cast(unsigned, f); return (u + 0x7fffu + ((u >> 16) & 1u)) >> 16; }
__device__ __forceinline__ unsigned pk2(float lo, float hi) { return f2bf(lo) | (f2bf(hi) << 16); }
__device__ __forceinline__ float bf2f(unsigned b) { return __builtin_bit_cast(float, b << 16); }
typedef __bf16 bf16x2_t __attribute__((ext_vector_type(2)));
__device__ __forceinline__ unsigned cvtpk(float lo, float hi) { f32x2 v = {lo, hi}; bf16x2_t b = __builtin_convertvector(v, bf16x2_t); return __builtin_bit_cast(unsigned, b); }
__device__ __forceinline__ v2u pack4(f32x4 v) { v2u r; r.x = cvtpk(v[0], v[1]); r.y = cvtpk(v[2], v[3]); return r; }
__device__ __forceinline__ float wave_sum(float v) {
#pragma unroll
    for (int o = 1; o < 64; o <<= 1) v += __shfl_xor(v, o);
    return v;
}

#define XB_TMO      128
#define XB_XCNT(j)  (256  + 64 * (j))
#define XB_XSUB(j)  (1280 + 64 * (j))
#define XB_XGEN(j)  (2304 + 64 * (j))
#define XB_TOP      3328
#define XB_TOPGEN   3392
#define XCD_BAR_WORDS 3456
#define XB_SPIN_CAP (1u << 18)
__device__ __forceinline__ unsigned xb_ld(unsigned* p)              { return __hip_atomic_load(p, __ATOMIC_RELAXED, __HIP_MEMORY_SCOPE_AGENT); }
__device__ __forceinline__ unsigned xb_add(unsigned* p, unsigned v) { return __hip_atomic_fetch_add(p, v, __ATOMIC_RELAXED, __HIP_MEMORY_SCOPE_AGENT); }
__device__ __forceinline__ unsigned xb_xcc_id() { return (unsigned)__builtin_amdgcn_s_getreg((3 << 11) | 20) & 0xFu; }
#define XB_SPIN(cond, bar) do { unsigned _sp = 0; while (cond) { __builtin_amdgcn_s_sleep(1); \
    if ((++_sp & 255u) == 0u) { if (xb_ld(&(bar)[XB_TMO])) break; if (_sp > XB_SPIN_CAP) { atomicAdd(&(bar)[XB_TMO], 1u); break; } } } } while (0)
struct XcdBarrier { unsigned* bar; unsigned x; volatile LAS unsigned* st; };
__device__ __forceinline__ XcdBarrier xcd_barrier_post(unsigned* bar, volatile LAS unsigned* st) {
    XcdBarrier b; b.bar = bar; b.x = xb_xcc_id(); b.st = st;
    if (threadIdx.x == 0) (void)xb_add(&bar[XB_XCNT(b.x)], 1u);
    return b;
}
__device__ __forceinline__ void xcd_barrier_complete(unsigned* bar, unsigned x, unsigned& nloc, unsigned& nx) {
    const unsigned G = gridDim.x * gridDim.y * gridDim.z;
    unsigned sum, cnt, mine, sp = 0u;
    for (;;) {
        sum = 0u; cnt = 0u; mine = 0u;
#pragma unroll
        for (unsigned j = 0; j < 16; ++j) { const unsigned c = xb_ld(&bar[XB_XCNT(j)]); sum += c; cnt += (c > 0u) ? 1u : 0u; mine = (j == x) ? c : mine; }
        if (sum == G) break;
        __builtin_amdgcn_s_sleep(1);
        if ((++sp & 255u) == 0u) { if (xb_ld(&bar[XB_TMO])) break; if (sp > XB_SPIN_CAP) { atomicAdd(&bar[XB_TMO], 1u); break; } }
    }
    nloc = mine > 0u ? mine : 1u; nx = cnt > 0u ? cnt : 1u;
}
__device__ __forceinline__ void xcd_barrier(const XcdBarrier& b) {
    asm volatile("s_waitcnt vmcnt(0)" ::: "memory");
    __syncthreads();
    if (threadIdx.x == 0) {
        unsigned* bar = b.bar;
        __builtin_amdgcn_s_waitcnt(0);
        unsigned nloc = b.st[0], nx = b.st[1];
        if (nloc == 0u) { xcd_barrier_complete(bar, b.x, nloc, nx); b.st[0] = nloc; b.st[1] = nx; }
        const unsigned old = xb_add(&bar[XB_XSUB(b.x)], 1u);
        const unsigned gen = old / nloc;
        if (old + 1u == (gen + 1u) * nloc) {
            __builtin_amdgcn_fence(__ATOMIC_RELEASE, "agent");
            asm volatile("s_waitcnt vmcnt(0)" ::: "memory");
            const unsigned og = xb_add(&bar[XB_TOP], 1u);
            const unsigned tg = og / nx;
            if (og + 1u == (tg + 1u) * nx) xb_add(&bar[XB_TOPGEN], 1u);
            else XB_SPIN(xb_ld(&bar[XB_TOPGEN]) == tg, bar);
            __builtin_amdgcn_fence(__ATOMIC_ACQUIRE, "agent");
            xb_add(&bar[XB_XGEN(b.x)], 1u);
            asm volatile("s_waitcnt vmcnt(0)" ::: "memory");
        } else {
            XB_SPIN(xb_ld(&bar[XB_XGEN(b.x)]) == gen, bar);
            __builtin_amdgcn_fence(__ATOMIC_ACQUIRE, "agent");
            asm volatile("s_waitcnt vmcnt(0)" ::: "memory");
        }
    }
    __syncthreads();
}
namespace pg8 {
#define PG8_LAS __attribute__((address_space(3)))
typedef unsigned short bf16_t;
typedef short bf16x8 __attribute__((ext_vector_type(8)));
typedef float f32x4 __attribute__((ext_vector_type(4)));
typedef unsigned u32x4 __attribute__((ext_vector_type(4)));
constexpr int BM = 256, BK = 64, HALF = 128, HTB = HALF * BK * 2  , STAGE_BYTES = 8 * HTB, NXCD = 8, WGM = 8;

__host__ __device__ __forceinline__ int lds_byte(int r, int c) { const int st = (r >> 4) * 2 + (c >> 5), rr = r & 15, cc = c & 31, ob = rr * 64 + cc * 2; return st * 1024 + (ob ^ (((ob >> 9) & 1) << 5)); }
__host__ __device__ __forceinline__ void stage_rc(int b, int& R, int& C) { const int st = b / 1024, sb = b % 1024, swz = sb ^ (((sb >> 9) & 1) << 5); R = (st >> 1) * 16 + swz / 64; C = (st & 1) * 32 + (swz % 64) / 2; }
__host__ __device__ __forceinline__ int perm32(int rho) { const int n = rho >> 4, i = rho & 15; return 8 * (i >> 2) + 4 * n + (i & 3); }

struct Unit { int pm, pn; };
struct Gemm { const bf16_t* A; const bf16_t* Bt; int M, N, K; };

struct StaticOrder {
    int nM, nN, nwg, G, c;
    __host__ __device__ void init(int M, int N, int G_, int c_) { nM = M / BM; nN = N / BM; nwg = nM * nN; G = G_; c = c_; }
    __host__ __device__ bool next(int i, Unit& u) const {
        const long L = (long)i * G + c; if (L >= nwg) return false;
        int wgid = (int)L; { const int q = nwg / NXCD, r = nwg % NXCD, xcd = wgid % NXCD, off = wgid / NXCD; wgid = (xcd < r ? xcd * (q + 1) : r * (q + 1) + (xcd - r) * q) + off; }
        const int nig = WGM * nN, gid = wgid / nig, fm = gid * WGM, gsz = (nM - fm) < WGM ? (nM - fm) : WGM;
        u.pm = fm + ((wgid % nig) % gsz); u.pn = (wgid % nig) / gsz; return true;
    }
    __device__ __forceinline__ void a_ready(const Unit&) const {}
    __device__ __forceinline__ void done(const Unit&) const {}
};


typedef float f32x2e __attribute__((ext_vector_type(2)));
typedef unsigned u32x2e __attribute__((ext_vector_type(2)));
__device__ __forceinline__ unsigned cvtpk_e(float lo, float hi) { typedef __bf16 b2 __attribute__((ext_vector_type(2))); f32x2e v = {lo, hi}; b2 b = __builtin_convertvector(v, b2); return __builtin_bit_cast(unsigned, b); }
__device__ __forceinline__ u32x2e pack4e(f32x4 v) { u32x2e r; r.x = cvtpk_e(v[0], v[1]); r.y = cvtpk_e(v[2], v[3]); return r; }

struct EpiProj {
    static constexpr bool PERM = false, AFTER_DRAIN = false;
    float* ssq_q; float* ssq_kv; const f32x2e* cs;
    bf16_t* CQ; bf16_t* CKV; unsigned char* KM; bf16_t* DQ; unsigned char* DKI; unsigned char* DVI;
    __device__ __forceinline__ void operator()(const f32x4 (&acc)[2][2][4][2], const Unit& u, int wr, int wc, int fr, int fq) const {
        const int pn = u.pn;
        const int row0 = u.pm * BM + wr * 64 + fr;
        if (pn <= 2) {
#pragma unroll
            for (int ai = 0; ai < 2; ++ai)
#pragma unroll
                for (int m = 0; m < 4; ++m) {
                    const int row = row0 + ai * HALF + m * 16; float s = 0.f;
#pragma unroll
                    for (int bj = 0; bj < 2; ++bj) {
                        if (pn == 1 && bj == 1) continue;
#pragma unroll
                        for (int n = 0; n < 2; ++n) {
                            const f32x4 v = acc[ai][bj][m][n]; s += (v[0] * v[0] + v[1] * v[1]) + (v[2] * v[2] + v[3] * v[3]);
                            const int col = bj * HALF + wc * 32 + n * 16 + fq * 4;
                            if (pn == 2) *(u32x2e*)(CKV + (size_t)row * 256 + col) = pack4e(v);
                            else *(u32x2e*)(CQ + (size_t)row * 384 + pn * 256 + col) = pack4e(v);
                        }
                    }
                    s += __shfl_xor(s, 16); s += __shfl_xor(s, 32);
                    if (fq == 0) atomicAdd((pn == 2 ? ssq_kv : ssq_q) + row, s);
                }
            if (pn == 1 && wc == 0) {
#pragma unroll
                for (int ai = 0; ai < 2; ++ai)
#pragma unroll
                    for (int m = 0; m < 4; ++m) {
                        const int row = row0 + ai * HALF + m * 16;
                        const f32x4 x1 = acc[ai][1][m][0], x2 = acc[ai][1][m][1];
                        f32x4 o1, o2;
#pragma unroll
                        for (int i = 0; i < 4; ++i) { const f32x2e c = cs[(size_t)row * 32 + 2 * (4 * fq + i)]; o1[i] = x1[i] * c.x - x2[i] * c.y; o2[i] = x2[i] * c.x + x1[i] * c.y; }
                        const int b = row >> 11, sq = row & 2047, t = sq >> 6, kr = sq & 63;
                        const u32x2e w1 = pack4e(o1), w2 = pack4e(o2);
#pragma unroll
                        for (int h = 0; h < 8; ++h) {
                            unsigned char* base = KM + ((size_t)((b * 8 + h) * 32 + t)) * 12288 + kr * 16 + (fq & 1) * 8;
                            *(u32x2e*)(base + (8 + (fq >> 1)) * 1024) = w1;
                            *(u32x2e*)(base + (10 + (fq >> 1)) * 1024) = w2;
                        }
                    }
            }
        } else if (pn <= 6) {
            const int g = wc & 1; const bool isq = pn <= 4; const int pt = isq ? pn - 3 : pn - 5;
#pragma unroll
            for (int ai = 0; ai < 2; ++ai)
#pragma unroll
                for (int m = 0; m < 4; ++m) {
                    const int row = row0 + ai * HALF + m * 16;
                    const int f1 = 16 * g + 4 * fq;
                    const f32x4 cA = *(const f32x4*)(cs + (size_t)row * 32 + f1), cB = *(const f32x4*)(cs + (size_t)row * 32 + f1 + 2);
                    const int b = row >> 11, sq = row & 2047, t = sq >> 6, kr = sq & 63;
#pragma unroll
                    for (int bj = 0; bj < 2; ++bj) {
                        const int chunk = 4 * pt + 2 * bj + (wc >> 1);
                        const f32x4 x1 = acc[ai][bj][m][0], x2 = acc[ai][bj][m][1];
                        f32x4 o1, o2;
                        o1[0] = x1[0] * cA[0] - x2[0] * cA[1]; o2[0] = x2[0] * cA[0] + x1[0] * cA[1];
                        o1[1] = x1[1] * cA[2] - x2[1] * cA[3]; o2[1] = x2[1] * cA[2] + x1[1] * cA[3];
                        o1[2] = x1[2] * cB[0] - x2[2] * cB[1]; o2[2] = x2[2] * cB[0] + x1[2] * cB[1];
                        o1[3] = x1[3] * cB[2] - x2[3] * cB[3]; o2[3] = x2[3] * cB[2] + x1[3] * cB[3];
                        if (isq) {
                            o1 = o1 * QSCALE_D; o2 = o2 * QSCALE_D;
                            bf16_t* p = DQ + (size_t)row * 512 + chunk * 64 + f1;
                            *(u32x2e*)p = pack4e(o1); *(u32x2e*)(p + 32) = pack4e(o2);
                        } else {
                            unsigned char* base = DKI + ((size_t)((b * 8 + chunk) * 32 + t)) * 8192 + kr * 16 + (fq & 1) * 8 + (2 * g + (fq >> 1)) * 1024;
                            *(u32x2e*)base = pack4e(o1); *(u32x2e*)(base + 4096) = pack4e(o2);
                        }
                    }
                }
        } else {
#pragma unroll
            for (int ai = 0; ai < 2; ++ai)
#pragma unroll
                for (int m = 0; m < 4; ++m) {
                    const int row = row0 + ai * HALF + m * 16;
                    const int b = row >> 11, sq = row & 2047, t = sq >> 6, kr = sq & 63;
#pragma unroll
                    for (int bj = 0; bj < 2; ++bj) {
                        const int h4 = 2 * (pn - 7) + bj;
                        unsigned char* base = DVI + ((size_t)((b * 4 + h4) * 32 + t)) * 16384 + wc * 4096 + kr * 64 + fq * 8;
#pragma unroll
                        for (int n = 0; n < 2; ++n) *(u32x2e*)(base + n * 32) = pack4e(acc[ai][bj][m][n]);
                    }
                }
        }
    }
};

struct EpiMlaQ {
    static constexpr bool PERM = false, AFTER_DRAIN = false;
    const float* ssq_q; const f32x2e* cs; bf16_t* QM;
    __device__ __forceinline__ void operator()(const f32x4 (&acc)[2][2][4][2], const Unit& u, int wr, int wc, int fr, int fq) const {
        const int row0 = u.pm * BM + wr * 64 + fr;
        int hh[2], pp[2];
#pragma unroll
        for (int bj = 0; bj < 2; ++bj) { const int G = 8 * u.pn + 4 * bj + wc; hh[bj] = G / 3; pp[bj] = G - 3 * hh[bj]; }
#pragma unroll
        for (int ai = 0; ai < 2; ++ai)
#pragma unroll
            for (int m = 0; m < 4; ++m) {
                const int row = row0 + ai * HALF + m * 16;
                const float rs = __builtin_amdgcn_rsqf(ssq_q[row] * (1.0f / 384.0f) + EPS) * QSCALE_M;
#pragma unroll
                for (int bj = 0; bj < 2; ++bj) {
                    bf16_t* p = QM + ((unsigned)row * 768u + (unsigned)(hh[bj] * 96 + pp[bj] * 32 + fq * 4));
                    if (pp[bj] < 2) {
#pragma unroll
                        for (int n = 0; n < 2; ++n) *(u32x2e*)(p + n * 16) = pack4e(acc[ai][bj][m][n] * rs);
                    } else {
                        const f32x4 x1 = acc[ai][bj][m][0] * rs, x2 = acc[ai][bj][m][1] * rs; f32x4 o1, o2;
                        const f32x2e* cp = cs + ((unsigned)row * 32u + 8u * (unsigned)fq);
#pragma unroll
                        for (int i = 0; i < 4; ++i) { const f32x2e c = cp[2 * i]; o1[i] = x1[i] * c.x - x2[i] * c.y; o2[i] = x2[i] * c.x + x1[i] * c.y; }
                        *(u32x2e*)p = pack4e(o1); *(u32x2e*)(p + 16) = pack4e(o2);
                    }
                }
                asm volatile("" ::: "memory");
            }
    }
};
struct EpiMlaKV {
    static constexpr bool PERM = false, AFTER_DRAIN = false;
    const float* ssq_kv; unsigned char* KM; unsigned char* VM;
    __device__ __forceinline__ void operator()(const f32x4 (&acc)[2][2][4][2], const Unit& u, int wr, int wc, int fr, int fq) const {
        const int row0 = u.pm * BM + wr * 64 + fr;
        const int G0 = 8 * u.pn + wc, h0 = G0 >> 2, part = G0 & 3;
        const bool isk = part < 2;
        unsigned char* const B = isk ? KM : VM;
        const unsigned tile_b = isk ? 12288u : 8192u;
        const unsigned lane_off = isk ? (unsigned)((fq & 1) * 8 + (4 * part + (fq >> 1)) * 1024) : (unsigned)((part - 2) * 4096 + fq * 8);
        const unsigned row_b = isk ? 16u : 64u, n_b = isk ? 2048u : 32u;
#pragma unroll
        for (int ai = 0; ai < 2; ++ai)
#pragma unroll
            for (int m = 0; m < 4; ++m) {
                const int row = row0 + ai * HALF + m * 16;
                const float rs = __builtin_amdgcn_rsqf(ssq_kv[row] * (1.0f / 256.0f) + EPS);
                const unsigned b = (unsigned)row >> 11, sq = (unsigned)row & 2047u, t = sq >> 6, kr = sq & 63u;
#pragma unroll
                for (int bj = 0; bj < 2; ++bj) {
                    const unsigned off = ((b * 8u + (unsigned)(h0 + bj)) * 32u + t) * tile_b + kr * row_b + lane_off;
#pragma unroll
                    for (int n = 0; n < 2; ++n) *(u32x2e*)(B + off + n * n_b) = pack4e(acc[ai][bj][m][n] * rs);
                }
                asm volatile("" ::: "memory");
            }
    }
};
struct EpiWo {
    static constexpr bool PERM = false, AFTER_DRAIN = false;
    const float* x; float* H;
    __device__ __forceinline__ void operator()(const f32x4 (&acc)[2][2][4][2], const Unit& u, int wr, int wc, int fr, int fq) const {
        const int row0 = u.pm * BM + wr * 64 + fr, col0 = u.pn * BM + wc * 32 + 4 * fq;
#pragma unroll
        for (int ai = 0; ai < 2; ++ai)
#pragma unroll
            for (int m = 0; m < 4; ++m) { const size_t off = (size_t)(row0 + ai * HALF + m * 16) * 1024 + col0;
#pragma unroll
                for (int bj = 0; bj < 2; ++bj)
#pragma unroll
                    for (int n = 0; n < 2; ++n) *(f32x4*)(H + off + bj * HALF + n * 16) = *(const f32x4*)(x + off + bj * HALF + n * 16) + acc[ai][bj][m][n]; }
    }
};
struct EpiGateUp {
    static constexpr bool PERM = false, AFTER_DRAIN = false;
    const float* GW; bf16_t* HDN;
    __device__ __forceinline__ void operator()(const f32x4 (&acc)[2][2][4][2], const Unit& u, int wr, int wc, int fr, int fq) const {
        const int row0 = u.pm * BM + wr * 64 + fr, pl = u.pn & 1;
#pragma unroll
        for (int ai = 0; ai < 2; ++ai)
#pragma unroll
            for (int m = 0; m < 4; ++m) {
                const int row = row0 + ai * HALF + m * 16; const float gw = GW[row];
#pragma unroll
                for (int bj = 0; bj < 2; ++bj) {
                    const f32x4 a = acc[ai][bj][m][0], uu = acc[ai][bj][m][1]; f32x4 o;
#pragma unroll
                    for (int i = 0; i < 4; ++i) { const float sg = __builtin_amdgcn_rcpf(1.0f + __builtin_amdgcn_exp2f(-a[i] * LOG2E)); o[i] = a[i] * sg * uu[i] * gw; }
                    *(u32x2e*)(HDN + (size_t)row * 256 + 16 * (8 * pl + 4 * bj + wc) + 4 * fq) = pack4e(o);
                }
            }
    }
};
struct EpiDown {
    static constexpr bool PERM = false, AFTER_DRAIN = false;
    bf16_t* Y;
    __device__ __forceinline__ void operator()(const f32x4 (&acc)[2][2][4][2], const Unit& u, int wr, int wc, int fr, int fq) const {
        const int row0 = u.pm * BM + wr * 64 + fr, col0 = (u.pn & 3) * BM + wc * 32 + 4 * fq;
#pragma unroll
        for (int ai = 0; ai < 2; ++ai)
#pragma unroll
            for (int m = 0; m < 4; ++m) { const size_t off = (size_t)(row0 + ai * HALF + m * 16) * 1024 + col0;
#pragma unroll
                for (int bj = 0; bj < 2; ++bj)
#pragma unroll
                    for (int n = 0; n < 2; ++n) *(u32x2e*)(Y + off + bj * HALF + n * 16) = pack4e(acc[ai][bj][m][n]); }
    }
};
struct MoeOrder {
    const PG8_LAS int* pexp; int npan, ntn, G, vc;
    __device__ __forceinline__ void init(const PG8_LAS int* pexp_, int ntn_, int G_, int bx) { pexp = pexp_; ntn = ntn_; G = G_; vc = (G_ % 8 == 0) ? (bx % 8) * (G_ / 8) + bx / 8 : bx;
        npan = __builtin_amdgcn_readfirstlane(pexp_[MAXPANEL]); if (npan > MAXPANEL) npan = MAXPANEL; if (npan < 0) npan = 0; }
    __device__ __forceinline__ bool next(int i, Unit& u) const {
        const int L = i * G + vc; if (L >= npan * ntn) return false;
        const int p = L / ntn, pl = L - p * ntn; const int e = __builtin_amdgcn_readfirstlane(pexp[p]) & 31;
        u.pm = p; u.pn = e * ntn + pl; return true;
    }
    __device__ __forceinline__ void a_ready(const Unit&) const {}
    __device__ __forceinline__ void done(const Unit&) const {}
};
template <class Epi, class Sched, bool ALIGN_EPI = false, bool SP2 = false>
__device__ __forceinline__ void gemm_phase(PG8_LAS unsigned char* lds, const Gemm g, const Sched& S, const Epi& E) {
    const int tid = threadIdx.x, wid = __builtin_amdgcn_readfirstlane(tid >> 6), lane = tid & 63, wr = wid >> 2, wc = wid & 3, fr = lane & 15, fq = lane >> 4;
    int K_ = g.K; asm volatile("" : "+s"(K_));
    const int K = K_, nt = K / BK;
    unsigned voffA[2], voffB[2];
#pragma unroll
    for (int i = 0; i < 2; ++i) { int R, C; stage_rc(tid * 16 + i * 8192, R, C); const int Rb = Epi::PERM ? ((R & ~31) + perm32(R & 31)) : R;
        voffA[i] = (unsigned)(R * K + C) * 2u; voffB[i] = (unsigned)(Rb * K + C) * 2u; }
    const size_t kstep = (size_t)(BK * 2);
    const size_t hstep = (size_t)HALF * K * 2;
    const size_t tstep = 2 * hstep;
    const unsigned ldsw = (unsigned)wid * 1024u;
    const int aoff = lds_byte(wr * 64 + fr, fq * 8), boff = lds_byte(wc * 32 + fr, fq * 8);
#define PG8_SA(b, h) (((b) * 2 + (h)) * HTB)
#define PG8_SB(b, h) ((4 + (b) * 2 + (h)) * HTB)
#define PG8_STAGE(bufoff, gbase, voff) do { _Pragma("unroll") for (int _i = 0; _i < 2; ++_i) \
        __builtin_amdgcn_global_load_lds((const unsigned*)((const char*)(gbase) + (voff)[_i]), (PG8_LAS unsigned*)(lds + (bufoff) + ldsw + _i * 8192), 16, 0, 0); } while (0)
#define PG8_LDA(dst, b, h) do { _Pragma("unroll") for (int m = 0; m < 4; ++m) _Pragma("unroll") for (int k = 0; k < 2; ++k) dst[m][k] = *(const PG8_LAS bf16x8*)(lds + PG8_SA(b, h) + aoff + m * 2048 + k * 1024); } while (0)
#define PG8_LDB(dst, b, h) do { _Pragma("unroll") for (int n = 0; n < 2; ++n) _Pragma("unroll") for (int k = 0; k < 2; ++k) dst[n][k] = *(const PG8_LAS bf16x8*)(lds + PG8_SB(b, h) + boff + n * 2048 + k * 1024); } while (0)
#define PG8_MMA(ai, bj, At, Bt) do { __builtin_amdgcn_s_setprio(1); _Pragma("unroll") for (int m = 0; m < 4; ++m) _Pragma("unroll") for (int n = 0; n < 2; ++n) _Pragma("unroll") for (int k = 0; k < 2; ++k) \
        acc[ai][bj][m][n] = __builtin_amdgcn_mfma_f32_16x16x32_bf16(Bt[n][k], At[m][k], acc[ai][bj][m][n], 0, 0, 0); __builtin_amdgcn_s_setprio(0); } while (0)
#define PG8_WAIT_V(n) asm volatile("s_waitcnt vmcnt(" #n ")" ::: "memory")
#define PG8_WAIT_L(n) asm volatile("s_waitcnt lgkmcnt(" #n ")" ::: "memory")
#define PG8_BAR __builtin_amdgcn_s_barrier()
#define PG8_SCHED __builtin_amdgcn_sched_barrier(0)
    Unit cur, nxt; int ui = 0;
    if (!S.next(0, cur)) return;
    f32x4 acc[2][2][4][2];
#pragma unroll
    for (int a = 0; a < 2; ++a)
#pragma unroll
        for (int b = 0; b < 2; ++b)
#pragma unroll
            for (int m = 0; m < 4; ++m)
#pragma unroll
                for (int n = 0; n < 2; ++n) acc[a][b][m][n] = (f32x4){0.f, 0.f, 0.f, 0.f};
    bf16x8 At[4][2], B0[2][2], B1[2][2];
    const char* cA = (const char*)g.A + (size_t)cur.pm * tstep; const char* cB = (const char*)g.Bt + (size_t)cur.pn * tstep;
    S.a_ready(cur);
    if constexpr (SP2) {
        PG8_STAGE(PG8_SB(0, 0), cB, voffB); PG8_STAGE(PG8_SB(0, 1), cB + hstep, voffB); PG8_STAGE(PG8_SA(0, 0), cA, voffA); PG8_STAGE(PG8_SA(0, 1), cA + hstep, voffA);
        if (wr == 1) PG8_BAR;
        PG8_WAIT_V(2); PG8_BAR;
        PG8_STAGE(PG8_SB(1, 0), cB + kstep, voffB); PG8_STAGE(PG8_SA(1, 0), cA + kstep, voffA); PG8_STAGE(PG8_SB(1, 1), cB + hstep + kstep, voffB);
        PG8_WAIT_V(6); PG8_BAR;
    } else {
        PG8_STAGE(PG8_SB(0, 0), cB, voffB); PG8_STAGE(PG8_SA(0, 0), cA, voffA); PG8_STAGE(PG8_SB(0, 1), cB + hstep, voffB); PG8_STAGE(PG8_SA(0, 1), cA + hstep, voffA);
        if (wr == 1) PG8_BAR;
        PG8_WAIT_V(4); PG8_BAR;
        PG8_STAGE(PG8_SB(1, 0), cB + kstep, voffB); PG8_STAGE(PG8_SA(1, 0), cA + kstep, voffA); PG8_STAGE(PG8_SB(1, 1), cB + hstep + kstep, voffB);
        PG8_WAIT_V(6); PG8_BAR;
    }
    for (;;) {
        const bool has_next = S.next(ui + 1, nxt);
        const char* nA = has_next ? (const char*)g.A + (size_t)nxt.pm * tstep : cA; const char* nB = has_next ? (const char*)g.Bt + (size_t)nxt.pn * tstep : cB;
        for (int t = 0; t < nt; t += 2) {
            const bool last = (t == nt - 2);
            const char* a1 = cA + (size_t)(t + 1) * kstep;
            const char* a2 = last ? nA : cA + (size_t)(t + 2) * kstep; const char* b2 = last ? nB : cB + (size_t)(t + 2) * kstep;
            const char* a3 = a2 + kstep; const char* b3 = b2 + kstep;
            if (last && has_next) S.a_ready(nxt);
            if constexpr (SP2) {
            PG8_LDB(B0, 0, 0); PG8_LDB(B1, 0, 1); PG8_SCHED; PG8_LDA(At, 0, 0); PG8_STAGE(PG8_SA(1, 1), a1 + hstep, voffA);
            PG8_WAIT_V(8); PG8_WAIT_L(0); PG8_BAR; PG8_MMA(0, 0, At, B0); PG8_MMA(0, 1, At, B1); PG8_BAR; PG8_SCHED;
            PG8_LDA(At, 0, 1); PG8_STAGE(PG8_SB(0, 0), b2, voffB); PG8_STAGE(PG8_SB(0, 1), b2 + hstep, voffB); PG8_STAGE(PG8_SA(0, 0), a2, voffA);
            PG8_WAIT_V(8); PG8_WAIT_L(0); PG8_BAR; PG8_MMA(1, 0, At, B0); PG8_MMA(1, 1, At, B1); PG8_BAR; PG8_SCHED;
            PG8_LDB(B0, 1, 0); PG8_LDB(B1, 1, 1); PG8_SCHED; PG8_LDA(At, 1, 0); PG8_STAGE(PG8_SA(0, 1), a2 + hstep, voffA);
            PG8_WAIT_V(8); PG8_WAIT_L(0); PG8_BAR; PG8_MMA(0, 0, At, B0); PG8_MMA(0, 1, At, B1); PG8_BAR; PG8_SCHED;
            PG8_LDA(At, 1, 1); PG8_STAGE(PG8_SB(1, 0), b3, voffB); PG8_STAGE(PG8_SB(1, 1), b3 + hstep, voffB); PG8_STAGE(PG8_SA(1, 0), a3, voffA);
            PG8_WAIT_V(8); PG8_WAIT_L(0); PG8_BAR; PG8_MMA(1, 0, At, B0); PG8_MMA(1, 1, At, B1); PG8_BAR; PG8_SCHED;
            } else {
            PG8_LDB(B0, 0, 0); PG8_SCHED; PG8_LDA(At, 0, 0); PG8_STAGE(PG8_SA(1, 1), a1 + hstep, voffA);
            PG8_WAIT_L(8); PG8_BAR; PG8_WAIT_L(0); PG8_MMA(0, 0, At, B0); PG8_BAR; PG8_SCHED;
            PG8_LDB(B1, 0, 1); PG8_STAGE(PG8_SB(0, 0), b2, voffB);
            PG8_BAR; PG8_WAIT_L(0); PG8_MMA(0, 1, At, B1); PG8_BAR;
            PG8_LDA(At, 0, 1); PG8_STAGE(PG8_SA(0, 0), a2, voffA);
            PG8_BAR; PG8_WAIT_L(0); PG8_MMA(1, 0, At, B0); PG8_BAR; PG8_SCHED;
            PG8_STAGE(PG8_SB(0, 1), b2 + hstep, voffB);
            PG8_WAIT_V(6); PG8_BAR; PG8_MMA(1, 1, At, B1); PG8_BAR;
            PG8_LDB(B0, 1, 0); PG8_SCHED; PG8_LDA(At, 1, 0); PG8_STAGE(PG8_SA(0, 1), a2 + hstep, voffA);
            PG8_WAIT_L(8); PG8_BAR; PG8_WAIT_L(0); PG8_MMA(0, 0, At, B0); PG8_BAR; PG8_SCHED;
            PG8_LDB(B1, 1, 1); PG8_STAGE(PG8_SB(1, 0), b3, voffB);
            PG8_BAR; PG8_WAIT_L(0); PG8_MMA(0, 1, At, B1); PG8_BAR;
            PG8_LDA(At, 1, 1); PG8_STAGE(PG8_SA(1, 0), a3, voffA);
            PG8_BAR; PG8_WAIT_L(0); PG8_MMA(1, 0, At, B0); PG8_BAR; PG8_SCHED;
            PG8_STAGE(PG8_SB(1, 1), b3 + hstep, voffB);
            PG8_WAIT_V(6); PG8_BAR; PG8_MMA(1, 1, At, B1); PG8_BAR;
            }
        }
        if constexpr (ALIGN_EPI) { if (wr == 0) PG8_BAR; }
        if constexpr (!Epi::AFTER_DRAIN) { E(acc, cur, wr, wc, fr, fq); S.done(cur); }
        if (!has_next) break;
#pragma unroll
        for (int a = 0; a < 2; ++a)
#pragma unroll
            for (int b = 0; b < 2; ++b)
#pragma unroll
                for (int m = 0; m < 4; ++m)
#pragma unroll
                    for (int n = 0; n < 2; ++n) acc[a][b][m][n] = (f32x4){0.f, 0.f, 0.f, 0.f};
        cur = nxt; cA = nA; cB = nB; ++ui;
        if constexpr (ALIGN_EPI) { if (wr == 1) PG8_BAR; }
    }
    PG8_WAIT_V(0);
    if constexpr (!ALIGN_EPI) { if (wr == 0) PG8_BAR; }
    PG8_BAR;
    if constexpr (Epi::AFTER_DRAIN) { E.fused(acc, cur, wr, wc, fr, fq, lds, wid, lane); S.done(cur); }
#undef PG8_SA
#undef PG8_SB
#undef PG8_STAGE
#undef PG8_LDA
#undef PG8_LDB
#undef PG8_MMA
#undef PG8_WAIT_V
#undef PG8_WAIT_L
#undef PG8_BAR
#undef PG8_SCHED
}
}

namespace att {
typedef LAS const char* lds_cptr;
typedef short v4i16_t __attribute__((ext_vector_type(4)));
constexpr int KV_BUF = 28672, V_OFF = 12288;
constexpr int LDS_WS = 2 * KV_BUF;
constexpr int LDS_ST = LDS_WS + 2048;
constexpr int LDS_END = LDS_ST + 8 * 8192;
static_assert(LDS_END <= RING_BYTES, "attention LDS");
constexpr float THR = 8.f;
__device__ __forceinline__ int crow(int r, int hi) { return (r & 3) + 8 * (r >> 2) + 4 * hi; }
__device__ __forceinline__ s16x4 vtr(lds_cptr p) { return __builtin_bit_cast(s16x4, __builtin_amdgcn_ds_read_tr16_b64_v4i16((LAS v4i16_t*)p)); }
#define ATT_MFMA(a, b, c) __builtin_amdgcn_mfma_f32_32x32x16_bf16(a, b, c, 0, 0, 0)

template <int KCH, int VCH>
__device__ __forceinline__ void issue_tile(const unsigned char* ksrc, const unsigned char* vsrc, LAS unsigned char* dst, int wid) {
#pragma unroll
    for (int j = 0; j < (KCH + 7) / 8; ++j) { const int p = wid + 8 * j; if (p < KCH) __builtin_amdgcn_global_load_lds((const unsigned*)(ksrc + p * 1024), (LAS unsigned*)(dst + p * 1024), 16, 0, 0); }
#pragma unroll
    for (int j = 0; j < (VCH + 7) / 8; ++j) { const int p = wid + 8 * j; if (p < VCH) __builtin_amdgcn_global_load_lds((const unsigned*)(vsrc + p * 1024), (LAS unsigned*)(dst + V_OFF + p * 1024), 16, 0, 0); }
}

template <int DK, int DV>
__device__ __forceinline__ void attn_pass(const bf16* Qw, int qpitch, const unsigned char* kimg, const unsigned char* vimg, int qb, LAS unsigned char* lds, int wid, int lane, f32x16 (&o)[DV / 32]) {
    constexpr int KCH = DK / 8, VCH = DV / 8, KTB = KCH * 1024, VTB = VCH * 1024, ND0 = DK / 16, NDB = DV / 32;
    const int r32 = lane & 31, hi = lane >> 5;
    const int NT = 4 * qb + 4, tlast = 4 * qb + (wid >> 1);
    bf16x8 qr[ND0];
#pragma unroll
    for (int d0 = 0; d0 < ND0; ++d0) qr[d0] = *(const bf16x8*)(Qw + (size_t)r32 * qpitch + d0 * 16 + hi * 8);
#pragma unroll
    for (int d = 0; d < NDB; ++d) o[d] = f32x16{};
    float mref = -1e30f, l = 0.f;
    LAS float* wsf = (LAS float*)(lds + LDS_WS) + wid * 64;
    const unsigned char* ks = kimg + lane * 16; const unsigned char* vs = vimg + lane * 16;
    issue_tile<KCH, VCH>(ks, vs, lds, wid);
    VM_WAIT(); __syncthreads();
    for (int t = 0; t < NT; ++t) {
        const int buf = t & 1;
        if (t + 1 < NT) issue_tile<KCH, VCH>(ks + (size_t)(t + 1) * KTB, vs + (size_t)(t + 1) * VTB, lds + (buf ^ 1) * KV_BUF, wid);
        if (t <= tlast) {
            const lds_cptr kb = (lds_cptr)lds + buf * KV_BUF + hi * 1024 + r32 * 16;
            f32x16 p0 = f32x16{}, p1 = f32x16{};
#pragma unroll
            for (int d0 = 0; d0 < ND0; ++d0) {
                const bf16x8 k0 = *(const LAS bf16x8*)(kb + d0 * 2048), k1 = *(const LAS bf16x8*)(kb + d0 * 2048 + 512);
                p0 = ATT_MFMA(k0, qr[d0], p0); p1 = ATT_MFMA(k1, qr[d0], p1);
            }
            if (t == tlast) {
                const int lim = 32 * (wid & 1) + r32;
#pragma unroll
                for (int r = 0; r < 16; ++r) { const int kk = crow(r, hi); if (kk > lim) p0[r] = -INFINITY; if (kk + 32 > lim) p1[r] = -INFINITY; }
            }
            float rm = __builtin_fmaxf(p0[0], p1[0]);
#pragma unroll
            for (int r = 1; r < 16; ++r) rm = __builtin_fmaxf(__builtin_fmaxf(rm, p0[r]), p1[r]);
            { auto rr = __builtin_amdgcn_permlane32_swap(__float_as_uint(rm), __float_as_uint(rm), false, false); rm = __builtin_fmaxf(__uint_as_float(rr[0]), __uint_as_float(rr[1])); }
            if (__any(rm - mref > THR)) {
                const float mn = __builtin_fmaxf(mref, rm), f = __builtin_amdgcn_exp2f(mref - mn); l *= f; mref = mn;
                if (hi == 0) wsf[r32] = f;
                LDS_WAIT();
#pragma unroll
                for (int r = 0; r < 16; ++r) { const float fr_ = wsf[crow(r, hi)];
#pragma unroll
                    for (int d = 0; d < NDB; ++d) o[d][r] *= fr_; }
            }
            float s = 0.f;
#pragma unroll
            for (int r = 0; r < 16; ++r) { p0[r] = __builtin_amdgcn_exp2f(p0[r] - mref); p1[r] = __builtin_amdgcn_exp2f(p1[r] - mref); s += p0[r] + p1[r]; }
            l += s;
            bf16x8 pa[4];
            { v4u w;
              w.x = cvtpk(p0[0], p0[1]); w.y = cvtpk(p0[2], p0[3]); w.z = cvtpk(p0[4], p0[5]); w.w = cvtpk(p0[6], p0[7]); pa[0] = __builtin_bit_cast(bf16x8, w);
              w.x = cvtpk(p0[8], p0[9]); w.y = cvtpk(p0[10], p0[11]); w.z = cvtpk(p0[12], p0[13]); w.w = cvtpk(p0[14], p0[15]); pa[1] = __builtin_bit_cast(bf16x8, w);
              w.x = cvtpk(p1[0], p1[1]); w.y = cvtpk(p1[2], p1[3]); w.z = cvtpk(p1[4], p1[5]); w.w = cvtpk(p1[6], p1[7]); pa[2] = __builtin_bit_cast(bf16x8, w);
              w.x = cvtpk(p1[8], p1[9]); w.y = cvtpk(p1[10], p1[11]); w.z = cvtpk(p1[12], p1[13]); w.w = cvtpk(p1[14], p1[15]); pa[3] = __builtin_bit_cast(bf16x8, w); }
            const lds_cptr vp = (lds_cptr)lds + buf * KV_BUF + V_OFF + ((lane >> 4) & 1) * 32 + (lane & 3) * 8 + (4 * hi + ((lane & 15) >> 2)) * 64;
#pragma unroll
            for (int d = 0; d < NDB; ++d)
#pragma unroll
                for (int ksl = 0; ksl < 4; ++ksl) {
                    const s16x4 lo = vtr(vp + d * 4096 + ksl * 1024), hh = vtr(vp + d * 4096 + ksl * 1024 + 512);
                    const bf16x8 vf = (bf16x8){lo[0], lo[1], lo[2], lo[3], hh[0], hh[1], hh[2], hh[3]};
                    o[d] = ATT_MFMA(pa[ksl], vf, o[d]);
                }
        }
        VM_WAIT(); __syncthreads();
    }
    { auto rr = __builtin_amdgcn_permlane32_swap(__float_as_uint(l), __float_as_uint(l), false, false); l = __uint_as_float(rr[0]) + __uint_as_float(rr[1]); }
    if (hi == 0) wsf[32 + r32] = l;
    LDS_WAIT();
#pragma unroll
    for (int r = 0; r < 16; ++r) { const float rl = __builtin_amdgcn_rcpf(wsf[32 + crow(r, hi)]);
#pragma unroll
        for (int d = 0; d < NDB; ++d) o[d][r] *= rl; }
    LDS_WAIT();
}

struct AttnArgs { const bf16* QM; const unsigned char* KM; const unsigned char* VM; const bf16* DQ; const unsigned char* DKI; const unsigned char* DVI; bf16* ATT; const float* subln_g; float lam; };

__device__ __forceinline__ void mla_unit(const AttnArgs& A, int b, int h, int qb, LAS unsigned char* lds, int wid, int lane) {
    const int r32 = lane & 31, hi = lane >> 5; const size_t m0 = (size_t)b * SEQ + qb * 256 + wid * 32;
    f32x16 o[2];
    attn_pass<96, 64>(A.QM + m0 * 768 + h * 96, 768, A.KM + (size_t)((b * 8 + h) * 32) * 12288, A.VM + (size_t)((b * 8 + h) * 32) * 8192, qb, lds, wid, lane, o);
    LAS bf16* stg = (LAS bf16*)(lds + LDS_ST + wid * 8192);
#pragma unroll
    for (int r = 0; r < 16; ++r) { const int orow = crow(r, hi);
#pragma unroll
        for (int d = 0; d < 2; ++d) stg[orow * 64 + d * 32 + r32] = (bf16)f2bf(o[d][r]); }
    LDS_WAIT();
#pragma unroll
    for (int i = 0; i < 4; ++i) { const int row = i * 8 + (lane >> 3), ch = lane & 7; const v4u v = *(const LAS v4u*)(stg + row * 64 + ch * 8); *(v4u*)(A.ATT + (m0 + row) * 1024 + h * 64 + ch * 8) = v; }
    LDS_WAIT();
}
__device__ __forceinline__ void diff_unit(const AttnArgs& A, int b, int h4, int qb, LAS unsigned char* lds, int wid, int lane) {
    const int r32 = lane & 31, hi = lane >> 5; const size_t m0 = (size_t)b * SEQ + qb * 256 + wid * 32;
    LAS bf16* stg = (LAS bf16*)(lds + LDS_ST + wid * 8192);
    const unsigned char* vimg = A.DVI + (size_t)((b * 4 + h4) * 32) * 16384;
    {
        f32x16 o[4];
        attn_pass<64, 128>(A.DQ + m0 * 512 + (h4 * 2) * 64, 512, A.DKI + (size_t)((b * 8 + h4 * 2) * 32) * 8192, vimg, qb, lds, wid, lane, o);
#pragma unroll
        for (int r = 0; r < 16; ++r) { const int orow = crow(r, hi);
#pragma unroll
            for (int d = 0; d < 4; ++d) stg[orow * 128 + d * 32 + r32] = (bf16)f2bf(o[d][r]); }
    }
    {
        f32x16 o[4];
        attn_pass<64, 128>(A.DQ + m0 * 512 + (h4 * 2 + 1) * 64, 512, A.DKI + (size_t)((b * 8 + h4 * 2 + 1) * 32) * 8192, vimg, qb, lds, wid, lane, o);
        LDS_WAIT();
        const float lam = A.lam;
#pragma unroll
        for (int r = 0; r < 16; ++r) { const int orow = crow(r, hi);
#pragma unroll
            for (int d = 0; d < 4; ++d) { LAS bf16* p = stg + orow * 128 + d * 32 + r32; const float a1 = bf2f(*p); *p = (bf16)f2bf(a1 - lam * o[d][r]); } }
    }
    LDS_WAIT();
    {
        const int row = lane >> 1, hf = lane & 1;
        v4u v[8]; float ss = 0.f;
#pragma unroll
        for (int i = 0; i < 8; ++i) { v[i] = *(const LAS v4u*)(stg + row * 128 + hf * 64 + i * 8);
#pragma unroll
            for (int j = 0; j < 4; ++j) { const float x0 = bf2f(v[i][j] & 0xffffu), x1 = bf2f(v[i][j] >> 16); ss += x0 * x0 + x1 * x1; } }
        ss += __shfl_xor(ss, 1);
        const float rs = __builtin_amdgcn_rsqf(ss * (1.0f / 128.0f) + EPS) * (1.0f - LAM_INIT);
        bf16* op = A.ATT + (m0 + row) * 1024 + 512 + h4 * 128 + hf * 64;
        const float* gp = A.subln_g + hf * 64;
#pragma unroll
        for (int i = 0; i < 8; ++i) { v4u w;
#pragma unroll
            for (int j = 0; j < 4; ++j) { const float x0 = bf2f(v[i][j] & 0xffffu) * rs * gp[i * 8 + 2 * j], x1 = bf2f(v[i][j] >> 16) * rs * gp[i * 8 + 2 * j + 1]; w[j] = cvtpk(x0, x1); }
            *(v4u*)(op + i * 8) = w; }
    }
    LDS_WAIT();
}

__device__ __forceinline__ unsigned mla_list(int d, int& cnt) {
    switch (d) {
        case 0: cnt = 5; return 0x82B34u;
        case 1: cnt = 3; return 0x9DEu;
        case 2: cnt = 2; return 0x56u;
        case 3: cnt = 2; return 0x1Fu;
        case 4: cnt = 1; return 0x7u;
        case 5: cnt = 1; return 0xCu;
        case 6: cnt = 1; return 0xAu;
        default: cnt = 1; return 0x0u;
    }
}
__device__ __forceinline__ void attn_phase(const AttnArgs& A, LAS unsigned char* lds, int vcu, int G, int wid, int lane) {
    for (int v = vcu; v < 256; v += G) {
        const int g = v >> 3, d = v & 7, b = g >> 2;
        diff_unit(A, b, g & 3, d, lds, wid, lane);
        int cnt; unsigned lst = mla_list(d, cnt);
        for (int i = 0; i < cnt; ++i) { const int e = (lst >> (4 * i)) & 15; mla_unit(A, b, 2 * (g & 3) + (e >> 3), e & 7, lds, wid, lane); }
    }
}
#undef ATT_MFMA
}

constexpr int NWAVES = 8;
constexpr int N_LAUNCHES = MK_N_LAUNCHES;
constexpr int PER_PHASE = 10;
constexpr int PEXP_LDS_OFF = LDSCTL_OFF + 1024;

struct In {
    const float* x; const int* positions; const float* attn_norm_g; const float* w_in; const float* q_norm_g; const float* w_uq; const float* kv_norm_g; const float* w_ukv;
    const float* lq1; const float* lk1; const float* lq2; const float* lk2; const float* subln_g; const float* w_o; const float* ffn_norm_g; const float* w_rg; const float* b_rg;
    const float* w_re; const float* b_re; const float* w_gate; const float* w_up; const float* w_down; const float* final_g;
};
struct Args { In in; float* out; unsigned char* ws; int ph_lo, ph_hi, li, pad; };


__device__ const float INVF[32] = {1.f, 0.749894261f, 0.562341332f, 0.421696514f, 0.316227764f, 0.237137377f, 0.177827939f, 0.133352131f, 0.100000001f, 0.0749894157f, 0.0562341325f, 0.0421696529f, 0.0316227749f, 0.0237137377f,
    0.0177827943f, 0.0133352149f, 0.00999999978f, 0.00749894185f, 0.00562341325f, 0.00421696482f, 0.00316227763f, 0.00237137359f, 0.00177827943f, 0.00133352145f, 0.00100000005f, 0.000749894243f, 0.000562341302f, 0.000421696517f,
    0.000316227757f, 0.00023713737f, 0.00017782794f, 0.00013335215f};
__device__ __forceinline__ void sincos_acc(float a, float& s, float& c) {
    const double ad = (double)a, k = __builtin_rint(ad * 0.63661977236758134308), r = __builtin_fma(-k, 1.57079632679489661923, ad);
    const float x = (float)r, x2 = x * x; const int q = (int)k & 3;
    const float sp = x + x * x2 * ((-1.9515295891e-4f * x2 + 8.3321608736e-3f) * x2 - 1.6666654611e-1f);
    const float cp = 1.0f - 0.5f * x2 + x2 * x2 * ((2.443315711809948e-5f * x2 - 1.388731625493765e-3f) * x2 + 4.166664568298827e-2f);
    s = (q == 0) ? sp : (q == 1) ? cp : (q == 2) ? -sp : -cp;
    c = (q == 0) ? cp : (q == 1) ? -sp : (q == 2) ? -cp : sp;
}
template <class F> __device__ __forceinline__ void tr_item(const F& f, int K, bf16* WT, int kb, int nb, LAS float* scr, int lane) {
    const int k0 = 64 * kb, n0 = 32 * nb;
    const int st = f.col(n0 + (lane & 31));
#pragma unroll 8
    for (int i = 0; i < 32; ++i) { const int kk = 2 * i + (lane >> 5); scr[kk * 33 + (lane & 31)] = f.val(k0 + kk, st); }
    LDS_WAIT(); asm volatile("" ::: "memory");
    const int c = lane & 7;
#pragma unroll
    for (int j = 0; j < 4; ++j) { const int n = (lane >> 3) + 8 * j; const LAS float* s = scr + (8 * c) * 33 + n;
        v4u o; o.x = pk2(s[0 * 33], s[1 * 33]); o.y = pk2(s[2 * 33], s[3 * 33]); o.z = pk2(s[4 * 33], s[5 * 33]); o.w = pk2(s[6 * 33], s[7 * 33]);
        *(v4u*)(WT + (size_t)(n0 + n) * K + k0 + 8 * c) = o; }
    LDS_WAIT(); asm volatile("" ::: "memory");
}
__host__ __device__ __forceinline__ int win_src(int n) {
    if (n < 384) return n;
    if (n < 416) return 640 + (n - 384);
    if (n < 512) return -1;
    if (n < 768) return 384 + (n - 512);
    if (n < 1792) { const int q = n - 768, region = q >> 9, qq = q & 511, c = qq >> 6, w = qq & 63, g = w >> 5, p = w & 31, f = 16 * g + (p & 15) + 32 * (p >> 4);
        return (region ? 1184 : 672) + 64 * c + f; }
    return 1696 + (n - 1792);
}
struct SrcWin { const float* w; const float* g; __device__ __forceinline__ int col(int n) const { return win_src(n); }
    __device__ __forceinline__ float val(int k, int st) const { const float v = w[(size_t)k * IN_COLS + (st < 0 ? 0 : st)] * g[k]; return st < 0 ? 0.f : v; } };
struct SrcScaled { const float* w; const float* g; int N; __device__ __forceinline__ int col(int n) const { return n; }
    __device__ __forceinline__ float val(int k, int st) const { return w[(size_t)k * N + st] * g[k]; } };
struct SrcPlain { const float* w; int N; __device__ __forceinline__ int col(int n) const { return n; }
    __device__ __forceinline__ float val(int k, int st) const { return w[(size_t)k * N + st]; } };
struct SrcGU { const float* wg; const float* wu; __device__ __forceinline__ int col(int r) const { const int G = r >> 5, p = r & 31; return ((p >> 4) << 16) | (16 * G + (p & 15)); }
    __device__ __forceinline__ float val(int k, int st) const { const unsigned long long d = (unsigned long long)wu - (unsigned long long)wg; const float* w = (const float*)((unsigned long long)wg + ((st >> 16) ? d : 0ull)); return w[(size_t)k * DFF + (st & 0xffff)]; } };

__device__ __forceinline__ void p0_prologue(const In& I, unsigned char* ws, LAS unsigned char* lds, int vcu, int G, int wave, int lane) {
    LAS float* scr = (LAS float*)(lds + RING_OFF + wave * 16384);
    const int gw = vcu * NWAVES + wave, NGW = G * NWAVES;
    bf16* Win_t = (bf16*)(ws + WS_WIN); bf16* Wuq_t = (bf16*)(ws + WS_WUQ); bf16* Wukv_t = (bf16*)(ws + WS_WUKV); bf16* Wo_t = (bf16*)(ws + WS_WO); bf16* Wgu_t = (bf16*)(ws + WS_WGU); bf16* Wd_t = (bf16*)(ws + WS_WD);
    bf16* XB = (bf16*)(ws + WS_XB);
    for (int m = gw; m < T_TOK; m += NGW) {
        const f32x4* xr = (const f32x4*)(I.x + (size_t)m * DM) + lane;
        f32x4 v[4]; float s = 0.f;
#pragma unroll
        for (int j = 0; j < 4; ++j) { v[j] = xr[64 * j]; s += (v[j].x * v[j].x + v[j].y * v[j].y) + (v[j].z * v[j].z + v[j].w * v[j].w); }
        const float rs = 1.0f / sqrtf(wave_sum(s) * (1.0f / DM) + EPS);
        v2u* o8 = (v2u*)(XB + (size_t)m * DM) + lane;
#pragma unroll
        for (int j = 0; j < 4; ++j) { v2u w; w.x = pk2(v[j].x * rs, v[j].y * rs); w.y = pk2(v[j].z * rs, v[j].w * rs); o8[64 * j] = w; }
    }
    constexpr int I_IN = 16 * 72, I_UQ = 6 * 24, I_UKV = 4 * 32, I_O = 16 * 32, I_GU1 = 16 * 16, I_GU = NEXP * I_GU1, I_D1 = 4 * 32, I_D = NEXP * I_D1;
    constexpr int NITEMS = I_IN + I_UQ + I_UKV + I_O + I_GU + I_D;
    for (int it = gw; it < NITEMS; it += NGW) {
        int r = it;
        if (r < I_IN) { SrcWin f{I.w_in, I.attn_norm_g}; tr_item(f, 1024, Win_t, r / 72, r % 72, scr, lane); continue; } r -= I_IN;
        if (r < I_UQ) { SrcScaled f{I.w_uq, I.q_norm_g, 768}; tr_item(f, QR, Wuq_t, r / 24, r % 24, scr, lane); continue; } r -= I_UQ;
        if (r < I_UKV) { SrcScaled f{I.w_ukv, I.kv_norm_g, 1024}; tr_item(f, KVR, Wukv_t, r / 32, r % 32, scr, lane); continue; } r -= I_UKV;
        if (r < I_O) { SrcPlain f{I.w_o, 1024}; tr_item(f, 1024, Wo_t, r / 32, r % 32, scr, lane); continue; } r -= I_O;
        if (r < I_GU) { const int e = r / I_GU1, q = r % I_GU1; SrcGU f{I.w_gate + (size_t)e * DM * DFF, I.w_up + (size_t)e * DM * DFF}; tr_item(f, 1024, Wgu_t + (size_t)e * 512 * 1024, q / 16, q % 16, scr, lane); continue; } r -= I_GU;
        { const int e = r / I_D1, q = r % I_D1; SrcPlain f{I.w_down + (size_t)e * DFF * DM, 1024}; tr_item(f, DFF, Wd_t + (size_t)e * 1024 * DFF, q / 32, q % 32, scr, lane); }
    }
    f32x2* cs = (f32x2*)(ws + WS_CS);
    for (int idx = gw * 64 + lane; idx < T_TOK * 32; idx += NGW * 64) {
        const int m = idx >> 5, i = idx & 31;
        const float ang = (float)I.positions[m] * INVF[i];
        float sn, cn; sincos_acc(ang, sn, cn); f32x2 c; c.x = cn; c.y = sn; cs[idx] = c;
    }
    bf16* wrh = (bf16*)(ws + WS_WR); bf16* wrl = wrh + 48 * 1024;
    for (int idx = gw * 64 + lane; idx < 48 * 1024; idx += NGW * 64) {
        const int j = idx >> 10, k = idx & 1023;
        float w = j < 4 ? I.w_rg[k * 4 + j] : (j < 36 ? I.w_re[k * 32 + (j - 4)] : 0.f);
        w *= I.ffn_norm_g[k];
        const unsigned h = f2bf(w); wrh[idx] = (bf16)h; wrl[idx] = (bf16)f2bf(w - bf2f(h));
    }
}

__device__ __forceinline__ void route_phase(const In& I, const float* H, unsigned char* ws, LAS unsigned char* lds, int vcu, int G, int wave, int lane) {
    LAS unsigned* cnt_l = (LAS unsigned*)(lds + 0); LAS unsigned* base_l = (LAS unsigned*)(lds + 128);
    LAS float* lg = (LAS float*)(lds + 1024 + wave * 4096);
    const bf16* wrh = (const bf16*)(ws + WS_WR); const bf16* wrl = wrh + 48 * 1024;
    unsigned* gcnt = (unsigned*)(ws + WS_CTL) + CW_CNT;
    v4u* rec = (v4u*)(ws + WS_REC);
    const int tid = wave * 64 + lane;
    for (int grp = vcu; grp < T_TOK / 64; grp += G) {
        if (tid < 32) cnt_l[tid] = 0u;
        __syncthreads();
        int e0 = 0, e1 = 0; float w0 = 0.f, w1 = 0.f, rstd = 0.f; unsigned lr0 = 0, lr1 = 0;
        const int m0 = 64 * grp + 16 * wave;
        if (wave < 4) {
            const int rl = lane & 15, kg = lane >> 4;
            const float* hp = H + (size_t)(m0 + rl) * DM + 8 * kg;
            const bf16* bh = wrh + (size_t)rl * 1024 + 8 * kg; const bf16* bl = wrl + (size_t)rl * 1024 + 8 * kg;
            f32x4 acc[3]; acc[0] = f32x4{}; acc[1] = f32x4{}; acc[2] = f32x4{};
            float ssq = 0.f;
#pragma unroll 2
            for (int s = 0; s < 32; ++s) {
                const f32x4 a0 = *(const f32x4*)(hp + 32 * s), a1 = *(const f32x4*)(hp + 32 * s + 4);
                ssq += (a0[0] * a0[0] + a0[1] * a0[1]) + (a0[2] * a0[2] + a0[3] * a0[3]) + (a1[0] * a1[0] + a1[1] * a1[1]) + (a1[2] * a1[2] + a1[3] * a1[3]);
                unsigned hh[8], ll[8];
#pragma unroll
                for (int j = 0; j < 4; ++j) { hh[j] = f2bf(a0[j]); ll[j] = f2bf(a0[j] - bf2f(hh[j])); hh[4 + j] = f2bf(a1[j]); ll[4 + j] = f2bf(a1[j] - bf2f(hh[4 + j])); }
                v4u wh, wl;
                wh.x = hh[0] | (hh[1] << 16); wh.y = hh[2] | (hh[3] << 16); wh.z = hh[4] | (hh[5] << 16); wh.w = hh[6] | (hh[7] << 16);
                wl.x = ll[0] | (ll[1] << 16); wl.y = ll[2] | (ll[3] << 16); wl.z = ll[4] | (ll[5] << 16); wl.w = ll[6] | (ll[7] << 16);
                const bf16x8 ahi = __builtin_bit_cast(bf16x8, wh), alo = __builtin_bit_cast(bf16x8, wl);
#pragma unroll
                for (int cb = 0; cb < 3; ++cb) {
                    const bf16x8 bhi = *(const bf16x8*)(bh + (size_t)cb * 16 * 1024 + 32 * s), blo = *(const bf16x8*)(bl + (size_t)cb * 16 * 1024 + 32 * s);
                    acc[cb] = __builtin_amdgcn_mfma_f32_16x16x32_bf16(ahi, bhi, acc[cb], 0, 0, 0);
                    acc[cb] = __builtin_amdgcn_mfma_f32_16x16x32_bf16(alo, bhi, acc[cb], 0, 0, 0);
                    acc[cb] = __builtin_amdgcn_mfma_f32_16x16x32_bf16(ahi, blo, acc[cb], 0, 0, 0);
                }
            }
            ssq += __shfl_xor(ssq, 16); ssq += __shfl_xor(ssq, 32);
#pragma unroll
            for (int cb = 0; cb < 3; ++cb)
#pragma unroll
                for (int r = 0; r < 4; ++r) lg[(4 * kg + r) * 48 + 16 * cb + rl] = acc[cb][r];
            LDS_WAIT();
            if (lane < 16) {
                rstd = 1.0f / sqrtf(ssq * (1.0f / DM) + EPS);
                const LAS float* L = lg + lane * 48;
                float gl[4];
#pragma unroll
                for (int g = 0; g < 4; ++g) gl[g] = L[g] * rstd + I.b_rg[g];
                int gi = 0; float gm = gl[0];
#pragma unroll
                for (int g = 1; g < 4; ++g) if (gl[g] > gm) { gm = gl[g]; gi = g; }
                float ps = 0.f;
#pragma unroll
                for (int g = 0; g < 4; ++g) ps += __expf(gl[g] - gm);
                const float pg = 1.0f / ps;
                float el[8];
#pragma unroll
                for (int e = 0; e < 8; ++e) el[e] = L[4 + 8 * gi + e] * rstd + I.b_re[8 * gi + e];
                int i1 = 0; float l1 = el[0];
#pragma unroll
                for (int e = 1; e < 8; ++e) if (el[e] > l1) { l1 = el[e]; i1 = e; }
                int i2 = -1; float l2 = -INFINITY;
#pragma unroll
                for (int e = 0; e < 8; ++e) if (e != i1 && el[e] > l2) { l2 = el[e]; i2 = e; }
                const float ex = __expf(l2 - l1), wn1 = 1.0f / (1.0f + ex), wn2 = ex * wn1;
                e0 = 8 * gi + i1; e1 = 8 * gi + i2; w0 = pg * wn1; w1 = pg * wn2;
                lr0 = __hip_atomic_fetch_add(cnt_l + e0, 1u, __ATOMIC_RELAXED, __HIP_MEMORY_SCOPE_WORKGROUP);
                lr1 = __hip_atomic_fetch_add(cnt_l + e1, 1u, __ATOMIC_RELAXED, __HIP_MEMORY_SCOPE_WORKGROUP);
            }
        }
        __syncthreads();
        if (tid < 32) { const unsigned c = cnt_l[tid]; base_l[tid] = c ? __hip_atomic_fetch_add(gcnt + tid, c, __ATOMIC_RELAXED, __HIP_MEMORY_SCOPE_AGENT) : 0u; }
        __syncthreads();
        if (wave < 4 && lane < 16) {
            v4u r0, r1; r0.x = (unsigned)e0; r0.y = (unsigned)e1; r0.z = __float_as_uint(w0); r0.w = __float_as_uint(w1);
            r1.x = __float_as_uint(rstd); r1.y = base_l[e0] + lr0; r1.z = base_l[e1] + lr1; r1.w = 0u;
            rec[2 * (m0 + lane)] = r0; rec[2 * (m0 + lane) + 1] = r1;
        }
        __syncthreads();
    }
}

__device__ __forceinline__ void scatter_phase(const In& I, const float* H, unsigned char* ws, int vcu, int G, int wave, int lane) {
    const unsigned* gcnt = (const unsigned*)(ws + WS_CTL) + CW_CNT;
    v4u* rec = (v4u*)(ws + WS_REC); float* GW = (float*)(ws + WS_GW); int* pexp = (int*)(ws + WS_PEXP); bf16* TS = (bf16*)(ws + WS_TS);
    const unsigned c = lane < 32 ? gcnt[lane] : 0u; const unsigned pad = (c + 255u) & ~255u;
    unsigned incl = pad;
#pragma unroll
    for (int o = 1; o < 32; o <<= 1) { const unsigned t = __shfl_up(incl, o); if ((lane & 31) >= o) incl += t; }
    const unsigned base = incl - pad;
    if (vcu == 0 && wave == 0) {
        if (lane < 32) { const int p0 = (int)(base >> 8), np = (int)(pad >> 8); for (int p = 0; p < np; ++p) if (p0 + p < MAXPANEL) pexp[p0 + p] = lane; }
        if (lane == 31) pexp[MAXPANEL] = (int)((base + pad) >> 8);
    }
    const int gw = vcu * NWAVES + wave, NGW = G * NWAVES;
    for (int m = gw; m < T_TOK; m += NGW) {
        const v4u r0 = rec[2 * m], r1 = rec[2 * m + 1];
        const int e0 = (int)(r0.x & 31u), e1 = (int)(r0.y & 31u);
        unsigned s0 = __shfl(base, e0) + r1.y, s1 = __shfl(base, e1) + r1.z;
        if (s0 >= (unsigned)MAXSLOT) s0 = MAXSLOT - 1; if (s1 >= (unsigned)MAXSLOT) s1 = MAXSLOT - 1;
        const float rstd = __uint_as_float(r1.x);
        const f32x4* hr = (const f32x4*)(H + (size_t)m * DM) + lane; const f32x4* gr = (const f32x4*)I.ffn_norm_g + lane;
        v2u* o0 = (v2u*)(TS + (size_t)s0 * DM) + lane; v2u* o1 = (v2u*)(TS + (size_t)s1 * DM) + lane;
#pragma unroll
        for (int j = 0; j < 4; ++j) { const f32x4 v = hr[64 * j] * rstd * gr[64 * j]; const v2u w = pack4(v); o0[64 * j] = w; o1[64 * j] = w; }
        if (lane == 0) { GW[s0] = __uint_as_float(r0.z); GW[s1] = __uint_as_float(r0.w); v4u n1 = r1; n1.y = s0; n1.z = s1; rec[2 * m + 1] = n1; }
    }
}

__device__ __forceinline__ void final_phase(const In& I, float* HO, const unsigned char* ws, int vcu, int G, int wave, int lane) {
    const v4u* rec = (const v4u*)(ws + WS_REC); const bf16* Y = (const bf16*)(ws + WS_TS);
    const int gw = vcu * NWAVES + wave, NGW = G * NWAVES;
    for (int m = gw; m < T_TOK; m += NGW) {
        const v4u r1 = rec[2 * m + 1];
        const unsigned s0 = r1.y < (unsigned)MAXSLOT ? r1.y : MAXSLOT - 1, s1 = r1.z < (unsigned)MAXSLOT ? r1.z : MAXSLOT - 1;
        f32x4* hr = (f32x4*)(HO + (size_t)m * DM) + lane; const f32x4* gr = (const f32x4*)I.final_g + lane;
        const v2u* y0 = (const v2u*)(Y + (size_t)s0 * DM) + lane; const v2u* y1 = (const v2u*)(Y + (size_t)s1 * DM) + lane;
        f32x4 v[4]; float s = 0.f;
#pragma unroll
        for (int j = 0; j < 4; ++j) { const v2u a = y0[64 * j], b = y1[64 * j]; f32x4 t = hr[64 * j];
            t[0] += bf2f(a.x & 0xffffu) + bf2f(b.x & 0xffffu); t[1] += bf2f(a.x >> 16) + bf2f(b.x >> 16); t[2] += bf2f(a.y & 0xffffu) + bf2f(b.y & 0xffffu); t[3] += bf2f(a.y >> 16) + bf2f(b.y >> 16);
            v[j] = t; s += (t[0] * t[0] + t[1] * t[1]) + (t[2] * t[2] + t[3] * t[3]); }
        const float rs = 1.0f / sqrtf(wave_sum(s) * (1.0f / DM) + EPS);
#pragma unroll
        for (int j = 0; j < 4; ++j) hr[64 * j] = v[j] * rs * gr[64 * j];
    }
}

__global__ void __launch_bounds__(NWAVES * 64, 2) fwd_kernel(Args args) {
    extern __shared__ __attribute__((aligned(16))) unsigned char lds_raw[];
    LAS unsigned char* lds = (LAS unsigned char*)lds_raw;
    volatile LAS unsigned* MISC = (volatile LAS unsigned*)(lds + MISC_OFF);
    const int tid = threadIdx.x, lane = tid & 63, wave = __builtin_amdgcn_readfirstlane(tid >> 6);
    const int G = gridDim.x; const int bx = blockIdx.x; const int vcu = (G % 8 == 0) ? (bx % 8) * (G / 8) + bx / 8 : bx;
    unsigned char* ws = args.ws; const In& I = args.in;
    gu32* ctl = (gu32*)(ws + WS_CTL);
    for (int u = tid; u < (LDS_BYTES - LDSCTL_OFF) / 4; u += NWAVES * 64) ((LAS unsigned*)(lds + LDSCTL_OFF))[u] = 0u;
    __syncthreads();
    XcdBarrier bar; bar.bar = (unsigned*)(ctl + CW_BAR); bar.x = 0; bar.st = nullptr;
    if (N_LAUNCHES != PER_PHASE) bar = xcd_barrier_post((unsigned*)(ctl + CW_BAR), MISC + 8);
#define GRID_BAR() do { if (N_LAUNCHES == PER_PHASE) { if (tid == 0) __hip_atomic_store(ctl + CW_TMO, 0xBADBA0u, RLX_AGENT); } else { xcd_barrier(bar); } } while (0)
    const int lo = args.ph_lo, hi = args.ph_hi;
#ifndef PHMASK
#define PHMASK 0x3ff
#endif
#define IN(k) (((PHMASK >> (k)) & 1) && lo <= (k) && (k) < hi)
#define BOTH(k) (IN(k) && IN((k) + 1))
    float* Hbuf = args.out;

    if (IN(0)) { p0_prologue(I, ws, lds, vcu, G, wave, lane); if (BOTH(0)) GRID_BAR(); }

    if (IN(1)) {
        pg8::Gemm g{(const pg8::bf16_t*)(ws + WS_XB), (const pg8::bf16_t*)(ws + WS_WIN), T_TOK, NPROJ, DM};
        pg8::StaticOrder S; S.init(T_TOK, NPROJ, G, bx);
        pg8::EpiProj E{(float*)(ctl + CW_SSQQ), (float*)(ctl + CW_SSQKV), (const pg8::f32x2e*)(ws + WS_CS), (pg8::bf16_t*)(ws + WS_CQ), (pg8::bf16_t*)(ws + WS_CKV), ws + WS_KM, (pg8::bf16_t*)(ws + WS_DQ), ws + WS_DKI, ws + WS_DVI};
        pg8::gemm_phase<pg8::EpiProj, pg8::StaticOrder, true, true>(lds + RING_OFF, g, S, E);
        if (BOTH(1)) GRID_BAR();
    }

    if (IN(2)) {
#ifndef NO_Q
        { pg8::Gemm g{(const pg8::bf16_t*)(ws + WS_CQ), (const pg8::bf16_t*)(ws + WS_WUQ), T_TOK, 768, QR};
          pg8::StaticOrder S; S.init(T_TOK, 768, G, bx);
          pg8::EpiMlaQ E{(const float*)(ctl + CW_SSQQ), (const pg8::f32x2e*)(ws + WS_CS), (pg8::bf16_t*)(ws + WS_QM)};
          pg8::gemm_phase<pg8::EpiMlaQ, pg8::StaticOrder, true, true>(lds + RING_OFF, g, S, E); }
#endif
        __syncthreads();
#ifndef NO_KV
        { pg8::Gemm g{(const pg8::bf16_t*)(ws + WS_CKV), (const pg8::bf16_t*)(ws + WS_WUKV), T_TOK, 1024, KVR};
          pg8::StaticOrder S; S.init(T_TOK, 1024, G, (bx + 192) % G);
          pg8::EpiMlaKV E{(const float*)(ctl + CW_SSQKV), ws + WS_KM, ws + WS_VM};
          pg8::gemm_phase<pg8::EpiMlaKV, pg8::StaticOrder, true, true>(lds + RING_OFF, g, S, E); }
#endif
        if (BOTH(2)) GRID_BAR();
    }

    if (IN(3)) {
        float lam;
        { const float a = I.lq1[lane] * I.lk1[lane], b = I.lq2[lane] * I.lk2[lane]; lam = expf(wave_sum(a)) - expf(wave_sum(b)) + LAM_INIT; }
        att::AttnArgs A{(const bf16*)(ws + WS_QM), ws + WS_KM, ws + WS_VM, (const bf16*)(ws + WS_DQ), ws + WS_DKI, ws + WS_DVI, (bf16*)(ws + WS_ATT), I.subln_g, lam};
        __syncthreads();
        att::attn_phase(A, lds + RING_OFF, vcu, G, wave, lane);
        if (BOTH(3)) GRID_BAR();
    }

    if (IN(4)) {
        pg8::Gemm g{(const pg8::bf16_t*)(ws + WS_ATT), (const pg8::bf16_t*)(ws + WS_WO), T_TOK, DM, DM};
        pg8::StaticOrder S; S.init(T_TOK, DM, G, bx);
        pg8::EpiWo E{I.x, Hbuf};
        pg8::gemm_phase<pg8::EpiWo, pg8::StaticOrder, true, true>(lds + RING_OFF, g, S, E);
        if (BOTH(4)) GRID_BAR();
    }

    if (IN(5)) { __syncthreads(); route_phase(I, Hbuf, ws, lds + RING_OFF, vcu, G, wave, lane); if (BOTH(5)) GRID_BAR(); }

    if (IN(6)) { scatter_phase(I, Hbuf, ws, vcu, G, wave, lane); if (BOTH(6)) GRID_BAR(); }

    if (IN(7)) {
        LAS int* pl = (LAS int*)(lds + PEXP_LDS_OFF);
        if (tid <= MAXPANEL) pl[tid] = ((const int*)(ws + WS_PEXP))[tid];
        __syncthreads();
        pg8::Gemm g{(const pg8::bf16_t*)(ws + WS_TS), (const pg8::bf16_t*)(ws + WS_WGU), MAXSLOT, NEXP * 512, DM};
        pg8::MoeOrder S; S.init(pl, 2, G, bx);
        pg8::EpiGateUp E{(const float*)(ws + WS_GW), (pg8::bf16_t*)(ws + WS_HDN)};
        pg8::gemm_phase<pg8::EpiGateUp, pg8::MoeOrder, true, true>(lds + RING_OFF, g, S, E);
        if (BOTH(7)) GRID_BAR();
    }

    if (IN(8)) {
        LAS int* pl = (LAS int*)(lds + PEXP_LDS_OFF);
        if (tid <= MAXPANEL) pl[tid] = ((const int*)(ws + WS_PEXP))[tid];
        __syncthreads();
        pg8::Gemm g{(const pg8::bf16_t*)(ws + WS_HDN), (const pg8::bf16_t*)(ws + WS_WD), MAXSLOT, NEXP * 1024, DFF};
        pg8::MoeOrder S; S.init(pl, 4, G, bx);
        pg8::EpiDown E{(pg8::bf16_t*)(ws + WS_TS)};
        pg8::gemm_phase<pg8::EpiDown, pg8::MoeOrder, true, true>(lds + RING_OFF, g, S, E);
        if (BOTH(8)) GRID_BAR();
    }

    if (IN(9)) final_phase(I, Hbuf, ws, vcu, G, wave, lane);
#undef IN
#undef BOTH
#undef GRID_BAR
}

extern "C" void kernel_launch(void* const* d_in, const int* in_sizes, int n_in, void* d_out, int out_size, void* d_ws, size_t ws_size, hipStream_t stream) {
    static int grid = 0;
    if (grid == 0) {
        if (n_in != 23 || in_sizes[0] != T_TOK * DM || out_size != T_TOK * DM || ws_size < WS_END) { fprintf(stderr, "kernel_launch: unexpected problem shape (n_in %d, in0 %d, out %d, ws %zu)\n", n_in, n_in > 0 ? in_sizes[0] : -1, out_size, ws_size); grid = -1; return; }
        int dev = 0, cus = 0, per_cu = 0;
        if (hipGetDevice(&dev) != hipSuccess || hipDeviceGetAttribute(&cus, hipDeviceAttributeMultiprocessorCount, dev) != hipSuccess) { grid = -1; return; }
        if (hipFuncSetAttribute((const void*)fwd_kernel, hipFuncAttributeMaxDynamicSharedMemorySize, LDS_BYTES) != hipSuccess) { fprintf(stderr, "kernel_launch: hipFuncSetAttribute failed\n"); grid = -1; return; }
        if (hipOccupancyMaxActiveBlocksPerMultiprocessor(&per_cu, (const void*)fwd_kernel, NWAVES * 64, LDS_BYTES) != hipSuccess || per_cu < 1) { fprintf(stderr, "kernel_launch: occupancy query says %d blocks per CU\n", per_cu); }
        (void)hipGetLastError();
        grid = cus;
    }
    if (grid < 0) return;
    if (hipMemsetAsync((char*)d_ws + WS_CTL, 0, CTL_ZERO_BYTES, stream) != hipSuccess) { fprintf(stderr, "kernel_launch: memset failed\n"); return; }
    Args a{};
    const void** ip = (const void**)&a.in;
    for (int i = 0; i < 23; ++i) ip[i] = d_in[i];
    a.out = (float*)d_out; a.ws = (unsigned char*)d_ws;
    if (N_LAUNCHES == 1) {
        a.ph_lo = 0; a.ph_hi = PER_PHASE; a.li = 0;
        hipLaunchKernelGGL(fwd_kernel, dim3(grid), dim3(NWAVES * 64), LDS_BYTES, stream, a);
    } else {
        for (int li = 0; li < PER_PHASE; ++li) { a.ph_lo = li; a.ph_hi = li + 1; a.li = li; hipLaunchKernelGGL(fwd_kernel, dim3(grid), dim3(NWAVES * 64), LDS_BYTES, stream, a); }
    }
    const hipError_t le = hipPeekAtLastError();
    if (le != hipSuccess) fprintf(stderr, "kernel_launch: launch failed: %s\n", hipGetErrorName(le));
}
```

```cpp
#include <hip/hip_runtime.h>
#include <cstdio>
#include <cstdint>

#ifndef PROBE_PHASE
#define PROBE_PHASE -1
#endif
#ifndef REPEAT_MASK
#define REPEAT_MASK 0
#endif
#ifndef MK_N_LAUNCHES
#define MK_N_LAUNCHES 1
#endif

constexpr int NB = 8, SEQ = 2048, DM = 1024, T_TOK = NB * SEQ;
constexpr int IN_COLS = 2208, NPROJ = 2304;
constexpr int QR = 384, KVR = 256;
constexpr int NEXP = 32, DFF = 256;
constexpr int MAXPANEL = 160, MAXSLOT = MAXPANEL * 256;
constexpr float EPS = 1e-6f;
constexpr float LOG2E = 1.4426950408889634f;
constexpr float QSCALE_M = 0.10206207261596577f * LOG2E;
constexpr float QSCALE_D = 0.125f * LOG2E;
constexpr float LAM_INIT = 0.2f;

constexpr size_t MiB = 1u << 20;
constexpr size_t WS_CTL = 0, CTL_ZERO_BYTES = 1 * MiB;
constexpr size_t WS_WIN = 1 * MiB;
constexpr size_t WS_WUQ = 6 * MiB;
constexpr size_t WS_WUKV = 7 * MiB;
constexpr size_t WS_WO = 8 * MiB;
constexpr size_t WS_WGU = 10 * MiB;
constexpr size_t WS_WD = 42 * MiB;
constexpr size_t WS_CS = 58 * MiB;
constexpr size_t WS_WR = 62 * MiB;
constexpr size_t WS_REC = 62 * MiB + 256 * 1024;
constexpr size_t WS_GW = 63 * MiB;
constexpr size_t WS_PEXP = 63 * MiB + 256 * 1024;
constexpr size_t WS_XB = 64 * MiB;
constexpr size_t WS_ATT = WS_XB;
constexpr size_t WS_CQ = 96 * MiB;
constexpr size_t WS_CKV = 108 * MiB;
constexpr size_t WS_QM = 116 * MiB;
constexpr size_t WS_KM = 140 * MiB;
constexpr size_t WS_VM = 164 * MiB;
constexpr size_t WS_DQ = 180 * MiB;
constexpr size_t WS_DKI = 196 * MiB;
constexpr size_t WS_DVI = 212 * MiB;
constexpr size_t WS_TS = 96 * MiB;
constexpr size_t WS_HB = 196 * MiB;
constexpr size_t WS_TOK = 64 * MiB;
constexpr size_t WS_GWT = 66 * MiB, WS_RST = 68 * MiB;
constexpr size_t WS_HDN = 176 * MiB;
constexpr size_t WS_END = 228 * MiB;
constexpr int CW_TMO = 0;
constexpr int CW_BAR = 4096;
constexpr int CW_STAMP = 12288;
constexpr int CW_CNT = 8192;
constexpr int CW_SSQQ = 16384;
constexpr int CW_SSQKV = 49152;
static_assert((CW_SSQKV + 32768) * 4 <= (int)CTL_ZERO_BYTES, "ctl");

constexpr int RING_OFF = 0, RING_BYTES = 131072;
constexpr int LDSCTL_OFF = RING_BYTES, MISC_OFF = LDSCTL_OFF + 320;
constexpr int LDS_BYTES = 147456;

#define GAS __attribute__((address_space(1)))
#define LAS __attribute__((address_space(3)))
typedef unsigned short bf16;
typedef unsigned v4u __attribute__((ext_vector_type(4)));
typedef unsigned v2u __attribute__((ext_vector_type(2)));
typedef float f32x4 __attribute__((ext_vector_type(4)));
typedef float f32x2 __attribute__((ext_vector_type(2)));
typedef float f32x16 __attribute__((ext_vector_type(16)));
typedef short bf16x8 __attribute__((ext_vector_type(8)));
typedef short s16x4 __attribute__((ext_vector_type(4)));
typedef GAS unsigned gu32;
#define RLX_AGENT __ATOMIC_RELAXED, __HIP_MEMORY_SCOPE_AGENT
#define LDS_WAIT() asm volatile("s_waitcnt lgkmcnt(0)" ::: "memory")
#define VM_WAIT() asm volatile("s_waitcnt vmcnt(0)" ::: "memory")
__device__ __forceinline__ unsigned f2bf(float f) { unsigned u = __builtin_bit_cast(unsigned, f); return (u + 0x7fffu + ((u >> 16) & 1u)) >> 16; }
__device__ __forceinline__ unsigned pk2(float lo, float hi) { return f2bf(lo) | (f2bf(hi) << 16); }
__device__ __forceinline__ float bf2f(unsigned b) { return __builtin_bit_cast(float, b << 16); }
typedef __bf16 bf16x2_t __attribute__((ext_vector_type(2)));
__device__ __forceinline__ unsigned cvtpk(float lo, float hi) { f32x2 v = {lo, hi}; bf16x2_t b = __builtin_convertvector(v, bf16x2_t); return __builtin_bit_cast(unsigned, b); }
__device__ __forceinline__ v2u pack4(f32x4 v) { v2u r; r.x = cvtpk(v[0], v[1]); r.y = cvtpk(v[2], v[3]); return r; }
__device__ __forceinline__ float wave_sum(float v) {
#pragma unroll
    for (int o = 1; o < 64; o <<= 1) v += __shfl_xor(v, o);
    return v;
}

#define XB_TMO      128
#define XB_XCNT(j)  (256  + 64 * (j))
#define XB_XSUB(j)  (1280 + 64 * (j))
#define XB_XGEN(j)  (2304 + 64 * (j))
#define XB_TOP      3328
#define XB_TOPGEN   3392
#define XCD_BAR_WORDS 3456
#define XB_SPIN_CAP (1u << 18)
__device__ __forceinline__ unsigned xb_ld(unsigned* p)              { return __hip_atomic_load(p, __ATOMIC_RELAXED, __HIP_MEMORY_SCOPE_AGENT); }
__device__ __forceinline__ unsigned xb_add(unsigned* p, unsigned v) { return __hip_atomic_fetch_add(p, v, __ATOMIC_RELAXED, __HIP_MEMORY_SCOPE_AGENT); }
__device__ __forceinline__ unsigned xb_xcc_id() { return (unsigned)__builtin_amdgcn_s_getreg((3 << 11) | 20) & 0xFu; }
#define XB_SPIN(cond, bar) do { unsigned _sp = 0; while (cond) { __builtin_amdgcn_s_sleep(1); \
    if ((++_sp & 255u) == 0u) { if (xb_ld(&(bar)[XB_TMO])) break; if (_sp > XB_SPIN_CAP) { atomicAdd(&(bar)[XB_TMO], 1u); break; } } } } while (0)
struct XcdBarrier { unsigned* bar; unsigned x; volatile LAS unsigned* st; };
__device__ __forceinline__ XcdBarrier xcd_barrier_post(unsigned* bar, volatile LAS unsigned* st) {
    XcdBarrier b; b.bar = bar; b.x = xb_xcc_id(); b.st = st;
    if (threadIdx.x == 0) (void)xb_add(&bar[XB_XCNT(b.x)], 1u);
    return b;
}
__device__ __forceinline__ void xcd_barrier_complete(unsigned* bar, unsigned x, unsigned& nloc, unsigned& nx) {
    const unsigned G = gridDim.x * gridDim.y * gridDim.z;
    unsigned sum, cnt, mine, sp = 0u;
    for (;;) {
        sum = 0u; cnt = 0u; mine = 0u;
#pragma unroll
        for (unsigned j = 0; j < 16; ++j) { const unsigned c = xb_ld(&bar[XB_XCNT(j)]); sum += c; cnt += (c > 0u) ? 1u : 0u; mine = (j == x) ? c : mine; }
        if (sum == G) break;
        __builtin_amdgcn_s_sleep(1);
        if ((++sp & 255u) == 0u) { if (xb_ld(&bar[XB_TMO])) break; if (sp > XB_SPIN_CAP) { atomicAdd(&bar[XB_TMO], 1u); break; } }
    }
    nloc = mine > 0u ? mine : 1u; nx = cnt > 0u ? cnt : 1u;
}
__device__ __forceinline__ void xcd_barrier(const XcdBarrier& b) {
    asm volatile("s_waitcnt vmcnt(0)" ::: "memory");
    __syncthreads();
    if (threadIdx.x == 0) {
        unsigned* bar = b.bar;
        __builtin_amdgcn_s_waitcnt(0);
        unsigned nloc = b.st[0], nx = b.st[1];
        if (nloc == 0u) { xcd_barrier_complete(bar, b.x, nloc, nx); b.st[0] = nloc; b.st[1] = nx; }
        const unsigned old = xb_add(&bar[XB_XSUB(b.x)], 1u);
        const unsigned gen = old / nloc;
        if (old + 1u == (gen + 1u) * nloc) {
            __builtin_amdgcn_fence(__ATOMIC_RELEASE, "agent");
            asm volatile("s_waitcnt vmcnt(0)" ::: "memory");
            const unsigned og = xb_add(&bar[XB_TOP], 1u);
            const unsigned tg = og / nx;
            if (og + 1u == (tg + 1u) * nx) xb_add(&bar[XB_TOPGEN], 1u);
            else XB_SPIN(xb_ld(&bar[XB_TOPGEN]) == tg, bar);
            __builtin_amdgcn_fence(__ATOMIC_ACQUIRE, "agent");
            xb_add(&bar[XB_XGEN(b.x)], 1u);
            asm volatile("s_waitcnt vmcnt(0)" ::: "memory");
        } else {
            XB_SPIN(xb_ld(&bar[XB_XGEN(b.x)]) == gen, bar);
            __builtin_amdgcn_fence(__ATOMIC_ACQUIRE, "agent");
            asm volatile("s_waitcnt vmcnt(0)" ::: "memory");
        }
    }
    __syncthreads();
}
namespace pg8 {
#define PG8_LAS __attribute__((address_space(3)))
typedef unsigned short bf16_t;
typedef short bf16x8 __attribute__((ext_vector_type(8)));
typedef float f32x4 __attribute__((ext_vector_type(4)));
typedef unsigned u32x4 __attribute__((ext_vector_type(4)));
constexpr int BM = 256, BK = 64, HALF = 128, HTB = HALF * BK * 2  , STAGE_BYTES = 8 * HTB, NXCD = 8, WGM = 8;

__host__ __device__ __forceinline__ int lds_byte(int r, int c) { const int st = (r >> 4) * 2 + (c >> 5), rr = r & 15, cc = c & 31, ob = rr * 64 + cc * 2; return st * 1024 + (ob ^ (((ob >> 9) & 1) << 5)); }
__host__ __device__ __forceinline__ void stage_rc(int b, int& R, int& C) { const int st = b / 1024, sb = b % 1024, swz = sb ^ (((sb >> 9) & 1) << 5); R = (st >> 1) * 16 + swz / 64; C = (st & 1) * 32 + (swz % 64) / 2; }
__host__ __device__ __forceinline__ int perm32(int rho) { const int n = rho >> 4, i = rho & 15; return 8 * (i >> 2) + 4 * n + (i & 3); }

struct Unit { int pm, pn; };
struct Gemm { const bf16_t* A; const bf16_t* Bt; int M, N, K; };

struct StaticOrder {
    int nM, nN, nwg, G, c;
    __host__ __device__ void init(int M, int N, int G_, int c_) { nM = M / BM; nN = N / BM; nwg = nM * nN; G = G_; c = c_; }
    __host__ __device__ bool next(int i, Unit& u) const {
        const long L = (long)i * G + c; if (L >= nwg) return false;
        int wgid = (int)L; { const int q = nwg / NXCD, r = nwg % NXCD, xcd = wgid % NXCD, off = wgid / NXCD; wgid = (xcd < r ? xcd * (q + 1) : r * (q + 1) + (xcd - r) * q) + off; }
        const int nig = WGM * nN, gid = wgid / nig, fm = gid * WGM, gsz = (nM - fm) < WGM ? (nM - fm) : WGM;
        u.pm = fm + ((wgid % nig) % gsz); u.pn = (wgid % nig) / gsz; return true;
    }
    __device__ __forceinline__ void a_ready(const Unit&) const {}
    __device__ __forceinline__ void done(const Unit&) const {}
};


typedef float f32x2e __attribute__((ext_vector_type(2)));
typedef unsigned u32x2e __attribute__((ext_vector_type(2)));
__device__ __forceinline__ unsigned cvtpk_e(float lo, float hi) { typedef __bf16 b2 __attribute__((ext_vector_type(2))); f32x2e v = {lo, hi}; b2 b = __builtin_convertvector(v, b2); return __builtin_bit_cast(unsigned, b); }
__device__ __forceinline__ u32x2e pack4e(f32x4 v) { u32x2e r; r.x = cvtpk_e(v[0], v[1]); r.y = cvtpk_e(v[2], v[3]); return r; }

struct EpiProj {
    static constexpr bool PERM = false, AFTER_DRAIN = false;
    unsigned long long* ssq_q; unsigned long long* ssq_kv; const f32x2e* cs;
    bf16_t* CQ; bf16_t* CKV; unsigned char* KM; bf16_t* DQ; unsigned char* DKI; unsigned char* DVI;
    __device__ __forceinline__ void operator()(const f32x4 (&acc)[2][2][4][2], const Unit& u, int wr, int wc, int fr, int fq) const {
        const int pn = u.pn;
        const int row0 = u.pm * BM + wr * 64 + fr;
        if (pn <= 2) {
#pragma unroll
            for (int ai = 0; ai < 2; ++ai)
#pragma unroll
                for (int m = 0; m < 4; ++m) {
                    const int row = row0 + ai * HALF + m * 16; float s = 0.f;
#pragma unroll
                    for (int bj = 0; bj < 2; ++bj) {
                        if (pn == 1 && bj == 1) continue;
#pragma unroll
                        for (int n = 0; n < 2; ++n) {
                            const f32x4 v = acc[ai][bj][m][n]; s += (v[0] * v[0] + v[1] * v[1]) + (v[2] * v[2] + v[3] * v[3]);
                            const int col = bj * HALF + wc * 32 + n * 16 + fq * 4;
                            if (pn == 2) *(u32x2e*)(CKV + (size_t)row * 256 + col) = pack4e(v);
                            else *(u32x2e*)(CQ + (size_t)row * 384 + pn * 256 + col) = pack4e(v);
                        }
                    }
                    s += __shfl_xor(s, 16); s += __shfl_xor(s, 32);
                    if (fq == 0) atomicAdd((pn == 2 ? ssq_kv : ssq_q) + row, (unsigned long long)(s * 4294967296.0f));
                }
            if (pn == 1 && wc == 0) {
#pragma unroll
                for (int ai = 0; ai < 2; ++ai)
#pragma unroll
                    for (int m = 0; m < 4; ++m) {
                        const int row = row0 + ai * HALF + m * 16;
                        const f32x4 x1 = acc[ai][1][m][0], x2 = acc[ai][1][m][1];
                        f32x4 o1, o2;
#pragma unroll
                        for (int i = 0; i < 4; ++i) { const f32x2e c = cs[(size_t)row * 32 + 2 * (4 * fq + i)]; o1[i] = x1[i] * c.x - x2[i] * c.y; o2[i] = x2[i] * c.x + x1[i] * c.y; }
                        const int b = row >> 11, sq = row & 2047, t = sq >> 6, kr = sq & 63;
                        const u32x2e w1 = pack4e(o1), w2 = pack4e(o2);
#pragma unroll
                        for (int h = 0; h < 8; ++h) {
                            unsigned char* base = KM + ((size_t)((b * 8 + h) * 32 + t)) * 12288 + kr * 16 + (fq & 1) * 8;
                            *(u32x2e*)(base + (8 + (fq >> 1)) * 1024) = w1;
                            *(u32x2e*)(base + (10 + (fq >> 1)) * 1024) = w2;
                        }
                    }
            }
        } else if (pn <= 6) {
            const int g = wc & 1; const bool isq = pn <= 4; const int pt = isq ? pn - 3 : pn - 5;
#pragma unroll
            for (int ai = 0; ai < 2; ++ai)
#pragma unroll
                for (int m = 0; m < 4; ++m) {
                    const int row = row0 + ai * HALF + m * 16;
                    const int f1 = 16 * g + 4 * fq;
                    const f32x4 cA = *(const f32x4*)(cs + (size_t)row * 32 + f1), cB = *(const f32x4*)(cs + (size_t)row * 32 + f1 + 2);
                    const int b = row >> 11, sq = row & 2047, t = sq >> 6, kr = sq & 63;
#pragma unroll
                    for (int bj = 0; bj < 2; ++bj) {
                        const int chunk = 4 * pt + 2 * bj + (wc >> 1);
                        const f32x4 x1 = acc[ai][bj][m][0], x2 = acc[ai][bj][m][1];
                        f32x4 o1, o2;
                        o1[0] = x1[0] * cA[0] - x2[0] * cA[1]; o2[0] = x2[0] * cA[0] + x1[0] * cA[1];
                        o1[1] = x1[1] * cA[2] - x2[1] * cA[3]; o2[1] = x2[1] * cA[2] + x1[1] * cA[3];
                        o1[2] = x1[2] * cB[0] - x2[2] * cB[1]; o2[2] = x2[2] * cB[0] + x1[2] * cB[1];
                        o1[3] = x1[3] * cB[2] - x2[3] * cB[3]; o2[3] = x2[3] * cB[2] + x1[3] * cB[3];
                        if (isq) {
                            o1 = o1 * QSCALE_D; o2 = o2 * QSCALE_D;
                            bf16_t* p = DQ + (size_t)row * 512 + chunk * 64 + f1;
                            *(u32x2e*)p = pack4e(o1); *(u32x2e*)(p + 32) = pack4e(o2);
                        } else {
                            unsigned char* base = DKI + ((size_t)((b * 8 + chunk) * 32 + t)) * 8192 + kr * 16 + (fq & 1) * 8 + (2 * g + (fq >> 1)) * 1024;
                            *(u32x2e*)base = pack4e(o1); *(u32x2e*)(base + 4096) = pack4e(o2);
                        }
                    }
                }
        } else {
#pragma unroll
            for (int ai = 0; ai < 2; ++ai)
#pragma unroll
                for (int m = 0; m < 4; ++m) {
                    const int row = row0 + ai * HALF + m * 16;
                    const int b = row >> 11, sq = row & 2047, t = sq >> 6, kr = sq & 63;
#pragma unroll
                    for (int bj = 0; bj < 2; ++bj) {
                        const int h4 = 2 * (pn - 7) + bj;
                        unsigned char* base = DVI + ((size_t)((b * 4 + h4) * 32 + t)) * 16384 + wc * 4096 + kr * 64 + fq * 8;
#pragma unroll
                        for (int n = 0; n < 2; ++n) *(u32x2e*)(base + n * 32) = pack4e(acc[ai][bj][m][n]);
                    }
                }
        }
    }
};

struct EpiMlaQ {
    static constexpr bool PERM = false, AFTER_DRAIN = false;
    const unsigned long long* ssq_q; const f32x2e* cs; bf16_t* QM;
    __device__ __forceinline__ void operator()(const f32x4 (&acc)[2][2][4][2], const Unit& u, int wr, int wc, int fr, int fq) const {
        const int row0 = u.pm * BM + wr * 64 + fr;
        int hh[2], pp[2];
#pragma unroll
        for (int bj = 0; bj < 2; ++bj) { const int G = 8 * u.pn + 4 * bj + wc; hh[bj] = G / 3; pp[bj] = G - 3 * hh[bj]; }
#pragma unroll
        for (int ai = 0; ai < 2; ++ai)
#pragma unroll
            for (int m = 0; m < 4; ++m) {
                const int row = row0 + ai * HALF + m * 16;
                const float rs = __builtin_amdgcn_rsqf((float)ssq_q[row] * (2.3283064365386963e-10f / 384.0f) + EPS) * QSCALE_M;
#pragma unroll
                for (int bj = 0; bj < 2; ++bj) {
                    bf16_t* p = QM + ((unsigned)row * 768u + (unsigned)(hh[bj] * 96 + pp[bj] * 32 + fq * 4));
                    if (pp[bj] < 2) {
#pragma unroll
                        for (int n = 0; n < 2; ++n) *(u32x2e*)(p + n * 16) = pack4e(acc[ai][bj][m][n] * rs);
                    } else {
                        const f32x4 x1 = acc[ai][bj][m][0] * rs, x2 = acc[ai][bj][m][1] * rs; f32x4 o1, o2;
                        const f32x2e* cp = cs + ((unsigned)row * 32u + 8u * (unsigned)fq);
#pragma unroll
                        for (int i = 0; i < 4; ++i) { const f32x2e c = cp[2 * i]; o1[i] = x1[i] * c.x - x2[i] * c.y; o2[i] = x2[i] * c.x + x1[i] * c.y; }
                        *(u32x2e*)p = pack4e(o1); *(u32x2e*)(p + 16) = pack4e(o2);
                    }
                }
                asm volatile("" ::: "memory");
            }
    }
};
struct EpiMlaKV {
    static constexpr bool PERM = false, AFTER_DRAIN = false;
    const unsigned long long* ssq_kv; unsigned char* KM; unsigned char* VM;
    __device__ __forceinline__ void operator()(const f32x4 (&acc)[2][2][4][2], const Unit& u, int wr, int wc, int fr, int fq) const {
        const int row0 = u.pm * BM + wr * 64 + fr;
        const int G0 = 8 * u.pn + wc, h0 = G0 >> 2, part = G0 & 3;
        const bool isk = part < 2;
        unsigned char* const B = isk ? KM : VM;
        const unsigned tile_b = isk ? 12288u : 8192u;
        const unsigned lane_off = isk ? (unsigned)((fq & 1) * 8 + (4 * part + (fq >> 1)) * 1024) : (unsigned)((part - 2) * 4096 + fq * 8);
        const unsigned row_b = isk ? 16u : 64u, n_b = isk ? 2048u : 32u;
#pragma unroll
        for (int ai = 0; ai < 2; ++ai)
#pragma unroll
            for (int m = 0; m < 4; ++m) {
                const int row = row0 + ai * HALF + m * 16;
                const float rs = __builtin_amdgcn_rsqf((float)ssq_kv[row] * (2.3283064365386963e-10f / 256.0f) + EPS);
                const unsigned b = (unsigned)row >> 11, sq = (unsigned)row & 2047u, t = sq >> 6, kr = sq & 63u;
#pragma unroll
                for (int bj = 0; bj < 2; ++bj) {
                    const unsigned off = ((b * 8u + (unsigned)(h0 + bj)) * 32u + t) * tile_b + kr * row_b + lane_off;
#pragma unroll
                    for (int n = 0; n < 2; ++n) *(u32x2e*)(B + off + n * n_b) = pack4e(acc[ai][bj][m][n] * rs);
                }
                asm volatile("" ::: "memory");
            }
    }
};
struct EpiWo {
    static constexpr bool PERM = false, AFTER_DRAIN = false;
    const float* x; bf16_t* HB;
    __device__ __forceinline__ void operator()(const f32x4 (&acc)[2][2][4][2], const Unit& u, int wr, int wc, int fr, int fq) const {
        const int row0 = u.pm * BM + wr * 64 + fr, col0 = u.pn * BM + wc * 32 + 4 * fq;
#pragma unroll
        for (int ai = 0; ai < 2; ++ai)
#pragma unroll
            for (int m = 0; m < 4; ++m) { const unsigned off = (unsigned)(row0 + ai * HALF + m * 16) * 1024u + (unsigned)col0;
#pragma unroll
                for (int bj = 0; bj < 2; ++bj)
#pragma unroll
                    for (int n = 0; n < 2; ++n) *(u32x2e*)(HB + off + bj * HALF + n * 16) = pack4e(*(const f32x4*)(x + off + bj * HALF + n * 16) + acc[ai][bj][m][n]);
                asm volatile("" ::: "memory"); }
    }
};
struct EpiGateUp {
    static constexpr bool PERM = false, AFTER_DRAIN = false;
    const float* GWT; const float* RST; const PG8_LAS int* pbase; bf16_t* HDN;
    __device__ __forceinline__ void operator()(const f32x4 (&acc)[2][2][4][2], const Unit& u, int wr, int wc, int fr, int fq) const {
        const int e = u.pn >> 1, pl = u.pn & 1, j = u.pm - __builtin_amdgcn_readfirstlane(pbase[e]);
        const int r0 = wr * 64 + fr; const unsigned ib = (unsigned)(e * 16384 + 256 * j);
#pragma unroll
        for (int ai = 0; ai < 2; ++ai)
#pragma unroll
            for (int m = 0; m < 4; ++m) {
                const int r = r0 + ai * HALF + m * 16; const float gw = GWT[ib + r], rs = RST[ib + r];
#pragma unroll
                for (int bj = 0; bj < 2; ++bj) {
                    const f32x4 a = acc[ai][bj][m][0] * rs, uu = acc[ai][bj][m][1] * (rs * gw); f32x4 o;
#pragma unroll
                    for (int i = 0; i < 4; ++i) { const float sg = __builtin_amdgcn_rcpf(1.0f + __builtin_amdgcn_exp2f(-a[i] * LOG2E)); o[i] = a[i] * sg * uu[i]; }
                    *(u32x2e*)(HDN + (unsigned)(u.pm * BM + r) * 256u + (unsigned)(16 * (8 * pl + 4 * bj + wc) + 4 * fq)) = pack4e(o);
                }
                asm volatile("" ::: "memory");
            }
    }
};
struct EpiDown {
    static constexpr bool PERM = false, AFTER_DRAIN = false;
    bf16_t* Y;
    __device__ __forceinline__ void operator()(const f32x4 (&acc)[2][2][4][2], const Unit& u, int wr, int wc, int fr, int fq) const {
        const int row0 = u.pm * BM + wr * 64 + fr, col0 = (u.pn & 3) * BM + wc * 32 + 4 * fq;
#pragma unroll
        for (int ai = 0; ai < 2; ++ai)
#pragma unroll
            for (int m = 0; m < 4; ++m) { const size_t off = (size_t)(row0 + ai * HALF + m * 16) * 1024 + col0;
#pragma unroll
                for (int bj = 0; bj < 2; ++bj)
#pragma unroll
                    for (int n = 0; n < 2; ++n) *(u32x2e*)(Y + off + bj * HALF + n * 16) = pack4e(acc[ai][bj][m][n]); }
    }
};
struct MoeOrder {
    const PG8_LAS int* pexp; const PG8_LAS int* tokl; int npan, ntn, G, vc;
    __device__ __forceinline__ void init(const PG8_LAS int* pexp_, const PG8_LAS int* tokl_, int ntn_, int G_, int bx) { pexp = pexp_; tokl = tokl_; ntn = ntn_; G = G_; vc = (G_ % 8 == 0) ? (bx % 8) * (G_ / 8) + bx / 8 : bx;
        npan = __builtin_amdgcn_readfirstlane(pexp_[MAXPANEL]); if (npan > MAXPANEL) npan = MAXPANEL; if (npan < 0) npan = 0; }
    __device__ __forceinline__ bool next(int i, Unit& u) const {
        const int L = i * G + vc; if (L >= npan * ntn) return false;
        const int p = L / ntn, pl = L - p * ntn; const int e = __builtin_amdgcn_readfirstlane(pexp[p]) & 31;
        u.pm = p; u.pn = e * ntn + pl; return true;
    }
    __device__ __forceinline__ const PG8_LAS int* toks(int ui) const { return tokl + 256 * ui; }
    __device__ __forceinline__ void a_ready(const Unit&) const {}
    __device__ __forceinline__ void done(const Unit&) const {}
};
template <class Epi, class Sched, bool ALIGN_EPI = false, bool SP2 = false, bool GATHER = false>
__device__ __forceinline__ void gemm_phase(PG8_LAS unsigned char* lds, const Gemm g, const Sched& S, const Epi& E) {
    const int tid = threadIdx.x, wid = __builtin_amdgcn_readfirstlane(tid >> 6), lane = tid & 63, wr = wid >> 2, wc = wid & 3, fr = lane & 15, fq = lane >> 4;
    int K_ = g.K; asm volatile("" : "+s"(K_));
    const int K = K_, nt = K / BK;
    static_assert(!GATHER || SP2, "row gather is implemented on the SP2 loop only");
    unsigned voffA[2], voffB[2]; int gR0 = 0, gR1 = 0; unsigned gC0 = 0, gC1 = 0;
#pragma unroll
    for (int i = 0; i < 2; ++i) { int R, C; stage_rc(tid * 16 + i * 8192, R, C); const int Rb = Epi::PERM ? ((R & ~31) + perm32(R & 31)) : R;
        voffA[i] = (unsigned)(R * K + C) * 2u; voffB[i] = (unsigned)(Rb * K + C) * 2u; if (i == 0) { gR0 = R; gC0 = (unsigned)C * 2u; } else { gR1 = R; gC1 = (unsigned)C * 2u; } }
    const size_t kstep = (size_t)(BK * 2);
    const size_t hstep = (size_t)HALF * K * 2;
    const size_t tstep = 2 * hstep;
    const unsigned ldsw = (unsigned)wid * 1024u;
    const int aoff = lds_byte(wr * 64 + fr, fq * 8), boff = lds_byte(wc * 32 + fr, fq * 8);
#define PG8_SA(b, h) (((b) * 2 + (h)) * HTB)
#define PG8_SB(b, h) ((4 + (b) * 2 + (h)) * HTB)
#define PG8_STAGE(bufoff, gbase, voff) do { _Pragma("unroll") for (int _i = 0; _i < 2; ++_i) \
        __builtin_amdgcn_global_load_lds((const unsigned*)((const char*)(gbase) + (voff)[_i]), (PG8_LAS unsigned*)(lds + (bufoff) + ldsw + _i * 8192), 16, 0, 0); } while (0)
#define PG8_STAGE2(bufoff, gbase, v0, v1) do { \
        __builtin_amdgcn_global_load_lds((const unsigned*)((const char*)(gbase) + (v0)), (PG8_LAS unsigned*)(lds + (bufoff) + ldsw), 16, 0, 0); \
        __builtin_amdgcn_global_load_lds((const unsigned*)((const char*)(gbase) + (v1)), (PG8_LAS unsigned*)(lds + (bufoff) + ldsw + 8192), 16, 0, 0); } while (0)
#define PG8_STAGE_A(bufoff, gbase, h, nx) do { if constexpr (GATHER) { PG8_STAGE2(bufoff, gbase, (nx) ? gN##h##0 : gA##h##0, (nx) ? gN##h##1 : gA##h##1); } else { PG8_STAGE(bufoff, (gbase) + (h) * hstep, voffA); } } while (0)
#define PG8_GLOAD(P, tl) do { const PG8_LAS int* tl_ = (tl); const unsigned kb_ = (unsigned)K * 2u; \
        P##00 = (unsigned)tl_[gR0] * kb_ + gC0; P##01 = (unsigned)tl_[gR1] * kb_ + gC1; P##10 = (unsigned)tl_[HALF + gR0] * kb_ + gC0; P##11 = (unsigned)tl_[HALF + gR1] * kb_ + gC1; } while (0)
#define PG8_LDA(dst, b, h) do { _Pragma("unroll") for (int m = 0; m < 4; ++m) _Pragma("unroll") for (int k = 0; k < 2; ++k) dst[m][k] = *(const PG8_LAS bf16x8*)(lds + PG8_SA(b, h) + aoff + m * 2048 + k * 1024); } while (0)
#define PG8_LDB(dst, b, h) do { _Pragma("unroll") for (int n = 0; n < 2; ++n) _Pragma("unroll") for (int k = 0; k < 2; ++k) dst[n][k] = *(const PG8_LAS bf16x8*)(lds + PG8_SB(b, h) + boff + n * 2048 + k * 1024); } while (0)
#define PG8_MMA(ai, bj, At, Bt) do { __builtin_amdgcn_s_setprio(1); _Pragma("unroll") for (int m = 0; m < 4; ++m) _Pragma("unroll") for (int n = 0; n < 2; ++n) _Pragma("unroll") for (int k = 0; k < 2; ++k) \
        acc[ai][bj][m][n] = __builtin_amdgcn_mfma_f32_16x16x32_bf16(Bt[n][k], At[m][k], acc[ai][bj][m][n], 0, 0, 0); __builtin_amdgcn_s_setprio(0); } while (0)
#define PG8_WAIT_V(n) asm volatile("s_waitcnt vmcnt(" #n ")" ::: "memory")
#define PG8_WAIT_L(n) asm volatile("s_waitcnt lgkmcnt(" #n ")" ::: "memory")
#define PG8_BAR __builtin_amdgcn_s_barrier()
#define PG8_SCHED __builtin_amdgcn_sched_barrier(0)
    Unit cur, nxt; int ui = 0;
    if (!S.next(0, cur)) return;
    f32x4 acc[2][2][4][2];
#pragma unroll
    for (int a = 0; a < 2; ++a)
#pragma unroll
        for (int b = 0; b < 2; ++b)
#pragma unroll
            for (int m = 0; m < 4; ++m)
#pragma unroll
                for (int n = 0; n < 2; ++n) acc[a][b][m][n] = (f32x4){0.f, 0.f, 0.f, 0.f};
    bf16x8 At[4][2], B0[2][2], B1[2][2];
    const char* cA = (const char*)g.A + (GATHER ? (size_t)0 : (size_t)cur.pm * tstep); const char* cB = (const char*)g.Bt + (size_t)cur.pn * tstep;
    unsigned gA00 = 0, gA01 = 0, gA10 = 0, gA11 = 0, gN00 = 0, gN01 = 0, gN10 = 0, gN11 = 0;
    if constexpr (GATHER) { PG8_GLOAD(gA, S.toks(0)); }
    S.a_ready(cur);
    if constexpr (SP2) {
        PG8_STAGE(PG8_SB(0, 0), cB, voffB); PG8_STAGE(PG8_SB(0, 1), cB + hstep, voffB); PG8_STAGE_A(PG8_SA(0, 0), cA, 0, false); PG8_STAGE_A(PG8_SA(0, 1), cA, 1, false);
        if (wr == 1) PG8_BAR;
        PG8_WAIT_V(2); PG8_BAR;
        PG8_STAGE(PG8_SB(1, 0), cB + kstep, voffB); PG8_STAGE_A(PG8_SA(1, 0), cA + kstep, 0, false); PG8_STAGE(PG8_SB(1, 1), cB + hstep + kstep, voffB);
        PG8_WAIT_V(6); PG8_BAR;
    } else {
        PG8_STAGE(PG8_SB(0, 0), cB, voffB); PG8_STAGE(PG8_SA(0, 0), cA, voffA); PG8_STAGE(PG8_SB(0, 1), cB + hstep, voffB); PG8_STAGE(PG8_SA(0, 1), cA + hstep, voffA);
        if (wr == 1) PG8_BAR;
        PG8_WAIT_V(4); PG8_BAR;
        PG8_STAGE(PG8_SB(1, 0), cB + kstep, voffB); PG8_STAGE(PG8_SA(1, 0), cA + kstep, voffA); PG8_STAGE(PG8_SB(1, 1), cB + hstep + kstep, voffB);
        PG8_WAIT_V(6); PG8_BAR;
    }
    for (;;) {
        const bool has_next = S.next(ui + 1, nxt);
        if constexpr (GATHER) { if (has_next) { PG8_GLOAD(gN, S.toks(ui + 1)); } else { gN00 = gA00; gN01 = gA01; gN10 = gA10; gN11 = gA11; } }
        const char* nA = (has_next && !GATHER) ? (const char*)g.A + (size_t)nxt.pm * tstep : cA; const char* nB = has_next ? (const char*)g.Bt + (size_t)nxt.pn * tstep : cB;
        for (int t = 0; t < nt; t += 2) {
            const bool last = (t == nt - 2);
            const char* a1 = cA + (size_t)(t + 1) * kstep;
            const char* a2 = last ? nA : cA + (size_t)(t + 2) * kstep; const char* b2 = last ? nB : cB + (size_t)(t + 2) * kstep;
            const char* a3 = a2 + kstep; const char* b3 = b2 + kstep;
            if (last && has_next) S.a_ready(nxt);
            if constexpr (SP2) {
            PG8_LDB(B0, 0, 0); PG8_LDB(B1, 0, 1); PG8_SCHED; PG8_LDA(At, 0, 0); PG8_STAGE_A(PG8_SA(1, 1), a1, 1, false);
            PG8_WAIT_V(8); PG8_WAIT_L(0); PG8_BAR; PG8_MMA(0, 0, At, B0); PG8_MMA(0, 1, At, B1); PG8_BAR; PG8_SCHED;
            PG8_LDA(At, 0, 1); PG8_STAGE(PG8_SB(0, 0), b2, voffB); PG8_STAGE(PG8_SB(0, 1), b2 + hstep, voffB); PG8_STAGE_A(PG8_SA(0, 0), a2, 0, last);
            PG8_WAIT_V(8); PG8_WAIT_L(0); PG8_BAR; PG8_MMA(1, 0, At, B0); PG8_MMA(1, 1, At, B1); PG8_BAR; PG8_SCHED;
            PG8_LDB(B0, 1, 0); PG8_LDB(B1, 1, 1); PG8_SCHED; PG8_LDA(At, 1, 0); PG8_STAGE_A(PG8_SA(0, 1), a2, 1, last);
            PG8_WAIT_V(8); PG8_WAIT_L(0); PG8_BAR; PG8_MMA(0, 0, At, B0); PG8_MMA(0, 1, At, B1); PG8_BAR; PG8_SCHED;
            PG8_LDA(At, 1, 1); PG8_STAGE(PG8_SB(1, 0), b3, voffB); PG8_STAGE(PG8_SB(1, 1), b3 + hstep, voffB); PG8_STAGE_A(PG8_SA(1, 0), a3, 0, last);
            PG8_WAIT_V(8); PG8_WAIT_L(0); PG8_BAR; PG8_MMA(1, 0, At, B0); PG8_MMA(1, 1, At, B1); PG8_BAR; PG8_SCHED;
            } else {
            PG8_LDB(B0, 0, 0); PG8_SCHED; PG8_LDA(At, 0, 0); PG8_STAGE(PG8_SA(1, 1), a1 + hstep, voffA);
            PG8_WAIT_L(8); PG8_BAR; PG8_WAIT_L(0); PG8_MMA(0, 0, At, B0); PG8_BAR; PG8_SCHED;
            PG8_LDB(B1, 0, 1); PG8_STAGE(PG8_SB(0, 0), b2, voffB);
            PG8_BAR; PG8_WAIT_L(0); PG8_MMA(0, 1, At, B1); PG8_BAR;
            PG8_LDA(At, 0, 1); PG8_STAGE(PG8_SA(0, 0), a2, voffA);
            PG8_BAR; PG8_WAIT_L(0); PG8_MMA(1, 0, At, B0); PG8_BAR; PG8_SCHED;
            PG8_STAGE(PG8_SB(0, 1), b2 + hstep, voffB);
            PG8_WAIT_V(6); PG8_BAR; PG8_MMA(1, 1, At, B1); PG8_BAR;
            PG8_LDB(B0, 1, 0); PG8_SCHED; PG8_LDA(At, 1, 0); PG8_STAGE(PG8_SA(0, 1), a2 + hstep, voffA);
            PG8_WAIT_L(8); PG8_BAR; PG8_WAIT_L(0); PG8_MMA(0, 0, At, B0); PG8_BAR; PG8_SCHED;
            PG8_LDB(B1, 1, 1); PG8_STAGE(PG8_SB(1, 0), b3, voffB);
            PG8_BAR; PG8_WAIT_L(0); PG8_MMA(0, 1, At, B1); PG8_BAR;
            PG8_LDA(At, 1, 1); PG8_STAGE(PG8_SA(1, 0), a3, voffA);
            PG8_BAR; PG8_WAIT_L(0); PG8_MMA(1, 0, At, B0); PG8_BAR; PG8_SCHED;
            PG8_STAGE(PG8_SB(1, 1), b3 + hstep, voffB);
            PG8_WAIT_V(6); PG8_BAR; PG8_MMA(1, 1, At, B1); PG8_BAR;
            }
        }
        if constexpr (ALIGN_EPI) { if (wr == 0) PG8_BAR; }
        if constexpr (!Epi::AFTER_DRAIN) { E(acc, cur, wr, wc, fr, fq); S.done(cur); }
        if (!has_next) break;
#pragma unroll
        for (int a = 0; a < 2; ++a)
#pragma unroll
            for (int b = 0; b < 2; ++b)
#pragma unroll
                for (int m = 0; m < 4; ++m)
#pragma unroll
                    for (int n = 0; n < 2; ++n) acc[a][b][m][n] = (f32x4){0.f, 0.f, 0.f, 0.f};
        cur = nxt; cA = nA; cB = nB; ++ui; if constexpr (GATHER) { gA00 = gN00; gA01 = gN01; gA10 = gN10; gA11 = gN11; }
        if constexpr (ALIGN_EPI) { if (wr == 1) PG8_BAR; }
    }
    PG8_WAIT_V(0);
    if constexpr (!ALIGN_EPI) { if (wr == 0) PG8_BAR; }
    PG8_BAR;
    if constexpr (Epi::AFTER_DRAIN) { E.fused(acc, cur, wr, wc, fr, fq, lds, wid, lane); S.done(cur); }
#undef PG8_SA
#undef PG8_SB
#undef PG8_STAGE
#undef PG8_STAGE2
#undef PG8_STAGE_A
#undef PG8_GLOAD
#undef PG8_LDA
#undef PG8_LDB
#undef PG8_MMA
#undef PG8_WAIT_V
#undef PG8_WAIT_L
#undef PG8_BAR
#undef PG8_SCHED
}
}

namespace att {
typedef LAS const char* lds_cptr;
typedef short v4i16_t __attribute__((ext_vector_type(4)));
constexpr int KV_BUF = 28672, V_OFF = 12288;
constexpr int LDS_WS = 2 * KV_BUF;
constexpr int LDS_ST = LDS_WS + 2048;
constexpr int LDS_END = LDS_ST + 8 * 8192;
static_assert(LDS_END <= RING_BYTES, "attention LDS");
constexpr float THR = 8.f;
__device__ __forceinline__ int crow(int r, int hi) { return (r & 3) + 8 * (r >> 2) + 4 * hi; }
__device__ __forceinline__ s16x4 vtr(lds_cptr p) { return __builtin_bit_cast(s16x4, __builtin_amdgcn_ds_read_tr16_b64_v4i16((LAS v4i16_t*)p)); }
#define ATT_MFMA(a, b, c) __builtin_amdgcn_mfma_f32_32x32x16_bf16(a, b, c, 0, 0, 0)

template <int KCH, int VCH>
__device__ __forceinline__ void issue_tile(const unsigned char* ksrc, const unsigned char* vsrc, LAS unsigned char* dst, int wid) {
#pragma unroll
    for (int j = 0; j < (KCH + 7) / 8; ++j) { const int p = wid + 8 * j; if (p < KCH) __builtin_amdgcn_global_load_lds((const unsigned*)(ksrc + p * 1024), (LAS unsigned*)(dst + p * 1024), 16, 0, 0); }
#pragma unroll
    for (int j = 0; j < (VCH + 7) / 8; ++j) { const int p = wid + 8 * j; if (p < VCH) __builtin_amdgcn_global_load_lds((const unsigned*)(vsrc + p * 1024), (LAS unsigned*)(dst + V_OFF + p * 1024), 16, 0, 0); }
}

template <int DK, int DV>
__device__ __forceinline__ void attn_pass(const bf16* Qw, int qpitch, const unsigned char* kimg, const unsigned char* vimg, int qb, LAS unsigned char* lds, int wid, int lane, f32x16 (&o)[DV / 32]) {
    constexpr int KCH = DK / 8, VCH = DV / 8, KTB = KCH * 1024, VTB = VCH * 1024, ND0 = DK / 16, NDB = DV / 32;
    const int r32 = lane & 31, hi = lane >> 5;
    const int NT = 4 * qb + 4, tlast = 4 * qb + (wid >> 1);
    bf16x8 qr[ND0];
#pragma unroll
    for (int d0 = 0; d0 < ND0; ++d0) qr[d0] = *(const bf16x8*)(Qw + (size_t)r32 * qpitch + d0 * 16 + hi * 8);
#pragma unroll
    for (int d = 0; d < NDB; ++d) o[d] = f32x16{};
    float mref = -1e30f, l = 0.f;
    LAS float* wsf = (LAS float*)(lds + LDS_WS) + wid * 64;
    const unsigned char* ks = kimg + lane * 16; const unsigned char* vs = vimg + lane * 16;
    issue_tile<KCH, VCH>(ks, vs, lds, wid);
    VM_WAIT(); __syncthreads();
    for (int t = 0; t < NT; ++t) {
        const int buf = t & 1;
        if (t + 1 < NT) issue_tile<KCH, VCH>(ks + (size_t)(t + 1) * KTB, vs + (size_t)(t + 1) * VTB, lds + (buf ^ 1) * KV_BUF, wid);
        if (t <= tlast) {
            const lds_cptr kb = (lds_cptr)lds + buf * KV_BUF + hi * 1024 + r32 * 16;
            f32x16 p0 = f32x16{}, p1 = f32x16{};
#pragma unroll
            for (int d0 = 0; d0 < ND0; ++d0) {
                const bf16x8 k0 = *(const LAS bf16x8*)(kb + d0 * 2048), k1 = *(const LAS bf16x8*)(kb + d0 * 2048 + 512);
                p0 = ATT_MFMA(k0, qr[d0], p0); p1 = ATT_MFMA(k1, qr[d0], p1);
            }
            if (t == tlast) {
                const int lim = 32 * (wid & 1) + r32;
#pragma unroll
                for (int r = 0; r < 16; ++r) { const int kk = crow(r, hi); if (kk > lim) p0[r] = -INFINITY; if (kk + 32 > lim) p1[r] = -INFINITY; }
            }
            float rm = __builtin_fmaxf(p0[0], p1[0]);
#pragma unroll
            for (int r = 1; r < 16; ++r) rm = __builtin_fmaxf(__builtin_fmaxf(rm, p0[r]), p1[r]);
            { auto rr = __builtin_amdgcn_permlane32_swap(__float_as_uint(rm), __float_as_uint(rm), false, false); rm = __builtin_fmaxf(__uint_as_float(rr[0]), __uint_as_float(rr[1])); }
            if (__any(rm - mref > THR)) {
                const float mn = __builtin_fmaxf(mref, rm), f = __builtin_amdgcn_exp2f(mref - mn); l *= f; mref = mn;
                if (hi == 0) wsf[r32] = f;
                LDS_WAIT();
#pragma unroll
                for (int r = 0; r < 16; ++r) { const float fr_ = wsf[crow(r, hi)];
#pragma unroll
                    for (int d = 0; d < NDB; ++d) o[d][r] *= fr_; }
            }
            float s = 0.f;
#pragma unroll
            for (int r = 0; r < 16; ++r) { p0[r] = __builtin_amdgcn_exp2f(p0[r] - mref); p1[r] = __builtin_amdgcn_exp2f(p1[r] - mref); s += p0[r] + p1[r]; }
            l += s;
            bf16x8 pa[4];
            { v4u w;
              w.x = cvtpk(p0[0], p0[1]); w.y = cvtpk(p0[2], p0[3]); w.z = cvtpk(p0[4], p0[5]); w.w = cvtpk(p0[6], p0[7]); pa[0] = __builtin_bit_cast(bf16x8, w);
              w.x = cvtpk(p0[8], p0[9]); w.y = cvtpk(p0[10], p0[11]); w.z = cvtpk(p0[12], p0[13]); w.w = cvtpk(p0[14], p0[15]); pa[1] = __builtin_bit_cast(bf16x8, w);
              w.x = cvtpk(p1[0], p1[1]); w.y = cvtpk(p1[2], p1[3]); w.z = cvtpk(p1[4], p1[5]); w.w = cvtpk(p1[6], p1[7]); pa[2] = __builtin_bit_cast(bf16x8, w);
              w.x = cvtpk(p1[8], p1[9]); w.y = cvtpk(p1[10], p1[11]); w.z = cvtpk(p1[12], p1[13]); w.w = cvtpk(p1[14], p1[15]); pa[3] = __builtin_bit_cast(bf16x8, w); }
            const lds_cptr vp = (lds_cptr)lds + buf * KV_BUF + V_OFF + ((lane >> 4) & 1) * 32 + (lane & 3) * 8 + (4 * hi + ((lane & 15) >> 2)) * 64;
#pragma unroll
            for (int d = 0; d < NDB; ++d)
#pragma unroll
                for (int ksl = 0; ksl < 4; ++ksl) {
                    const s16x4 lo = vtr(vp + d * 4096 + ksl * 1024), hh = vtr(vp + d * 4096 + ksl * 1024 + 512);
                    const bf16x8 vf = (bf16x8){lo[0], lo[1], lo[2], lo[3], hh[0], hh[1], hh[2], hh[3]};
                    o[d] = ATT_MFMA(pa[ksl], vf, o[d]);
                }
        }
        VM_WAIT(); __syncthreads();
    }
    { auto rr = __builtin_amdgcn_permlane32_swap(__float_as_uint(l), __float_as_uint(l), false, false); l = __uint_as_float(rr[0]) + __uint_as_float(rr[1]); }
    if (hi == 0) wsf[32 + r32] = l;
    LDS_WAIT();
#pragma unroll
    for (int r = 0; r < 16; ++r) { const float rl = __builtin_amdgcn_rcpf(wsf[32 + crow(r, hi)]);
#pragma unroll
        for (int d = 0; d < NDB; ++d) o[d][r] *= rl; }
    LDS_WAIT();
}

struct AttnArgs { const bf16* QM; const unsigned char* KM; const unsigned char* VM; const bf16* DQ; const unsigned char* DKI; const unsigned char* DVI; bf16* ATT; const float* subln_g; float lam; };

__device__ __forceinline__ void mla_unit(const AttnArgs& A, int b, int h, int qb, LAS unsigned char* lds, int wid, int lane) {
    const int r32 = lane & 31, hi = lane >> 5; const size_t m0 = (size_t)b * SEQ + qb * 256 + wid * 32;
    f32x16 o[2];
    attn_pass<96, 64>(A.QM + m0 * 768 + h * 96, 768, A.KM + (size_t)((b * 8 + h) * 32) * 12288, A.VM + (size_t)((b * 8 + h) * 32) * 8192, qb, lds, wid, lane, o);
    LAS bf16* stg = (LAS bf16*)(lds + LDS_ST + wid * 8192);
#pragma unroll
    for (int r = 0; r < 16; ++r) { const int orow = crow(r, hi);
#pragma unroll
        for (int d = 0; d < 2; ++d) stg[orow * 64 + d * 32 + r32] = (bf16)f2bf(o[d][r]); }
    LDS_WAIT();
#pragma unroll
    for (int i = 0; i < 4; ++i) { const int row = i * 8 + (lane >> 3), ch = lane & 7; const v4u v = *(const LAS v4u*)(stg + row * 64 + ch * 8); *(v4u*)(A.ATT + (m0 + row) * 1024 + h * 64 + ch * 8) = v; }
    LDS_WAIT();
}
__device__ __forceinline__ void diff_unit(const AttnArgs& A, int b, int h4, int qb, LAS unsigned char* lds, int wid, int lane) {
    const int r32 = lane & 31, hi = lane >> 5; const size_t m0 = (size_t)b * SEQ + qb * 256 + wid * 32;
    LAS bf16* stg = (LAS bf16*)(lds + LDS_ST + wid * 8192);
    const unsigned char* vimg = A.DVI + (size_t)((b * 4 + h4) * 32) * 16384;
    {
        f32x16 o[4];
        attn_pass<64, 128>(A.DQ + m0 * 512 + (h4 * 2) * 64, 512, A.DKI + (size_t)((b * 8 + h4 * 2) * 32) * 8192, vimg, qb, lds, wid, lane, o);
#pragma unroll
        for (int r = 0; r < 16; ++r) { const int orow = crow(r, hi);
#pragma unroll
            for (int d = 0; d < 4; ++d) stg[orow * 128 + d * 32 + r32] = (bf16)f2bf(o[d][r]); }
    }
    {
        f32x16 o[4];
        attn_pass<64, 128>(A.DQ + m0 * 512 + (h4 * 2 + 1) * 64, 512, A.DKI + (size_t)((b * 8 + h4 * 2 + 1) * 32) * 8192, vimg, qb, lds, wid, lane, o);
        LDS_WAIT();
        const float lam = A.lam;
#pragma unroll
        for (int r = 0; r < 16; ++r) { const int orow = crow(r, hi);
#pragma unroll
            for (int d = 0; d < 4; ++d) { LAS bf16* p = stg + orow * 128 + d * 32 + r32; const float a1 = bf2f(*p); *p = (bf16)f2bf(a1 - lam * o[d][r]); } }
    }
    LDS_WAIT();
    {
        const int row = lane >> 1, hf = lane & 1;
        v4u v[8]; float ss = 0.f;
#pragma unroll
        for (int i = 0; i < 8; ++i) { v[i] = *(const LAS v4u*)(stg + row * 128 + hf * 64 + i * 8);
#pragma unroll
            for (int j = 0; j < 4; ++j) { const float x0 = bf2f(v[i][j] & 0xffffu), x1 = bf2f(v[i][j] >> 16); ss += x0 * x0 + x1 * x1; } }
        ss += __shfl_xor(ss, 1);
        const float rs = __builtin_amdgcn_rsqf(ss * (1.0f / 128.0f) + EPS) * (1.0f - LAM_INIT);
        bf16* op = A.ATT + (m0 + row) * 1024 + 512 + h4 * 128 + hf * 64;
        const float* gp = A.subln_g + hf * 64;
#pragma unroll
        for (int i = 0; i < 8; ++i) { v4u w;
#pragma unroll
            for (int j = 0; j < 4; ++j) { const float x0 = bf2f(v[i][j] & 0xffffu) * rs * gp[i * 8 + 2 * j], x1 = bf2f(v[i][j] >> 16) * rs * gp[i * 8 + 2 * j + 1]; w[j] = cvtpk(x0, x1); }
            *(v4u*)(op + i * 8) = w; }
    }
    LDS_WAIT();
}

__device__ __forceinline__ unsigned mla_list(int d, int& cnt) {
    switch (d) {
        case 0: cnt = 5; return 0x82B34u;
        case 1: cnt = 3; return 0x9DEu;
        case 2: cnt = 2; return 0x56u;
        case 3: cnt = 2; return 0x1Fu;
        case 4: cnt = 1; return 0x7u;
        case 5: cnt = 1; return 0xCu;
        case 6: cnt = 1; return 0xAu;
        default: cnt = 1; return 0x0u;
    }
}
__device__ __forceinline__ void attn_phase(const AttnArgs& A, LAS unsigned char* lds, int vcu, int G, int wid, int lane) {
    for (int v = vcu; v < 256; v += G) {
        const int g = v >> 3, d = v & 7, b = g >> 2;
        diff_unit(A, b, g & 3, d, lds, wid, lane);
        int cnt; unsigned lst = mla_list(d, cnt);
        for (int i = 0; i < cnt; ++i) { const int e = (lst >> (4 * i)) & 15; mla_unit(A, b, 2 * (g & 3) + (e >> 3), e & 7, lds, wid, lane); }
    }
}
#undef ATT_MFMA
}

constexpr int NWAVES = 8;
constexpr int N_LAUNCHES = MK_N_LAUNCHES;
constexpr int PER_PHASE = 10;
constexpr int PEXP_LDS_OFF = LDSCTL_OFF + 1024;

struct In {
    const float* x; const int* positions; const float* attn_norm_g; const float* w_in; const float* q_norm_g; const float* w_uq; const float* kv_norm_g; const float* w_ukv;
    const float* lq1; const float* lk1; const float* lq2; const float* lk2; const float* subln_g; const float* w_o; const float* ffn_norm_g; const float* w_rg; const float* b_rg;
    const float* w_re; const float* b_re; const float* w_gate; const float* w_up; const float* w_down; const float* final_g;
};
struct Args { In in; float* out; unsigned char* ws; int ph_lo, ph_hi, li, pad; };


__device__ const float INVF[32] = {1.f, 0.749894261f, 0.562341332f, 0.421696514f, 0.316227764f, 0.237137377f, 0.177827939f, 0.133352131f, 0.100000001f, 0.0749894157f, 0.0562341325f, 0.0421696529f, 0.0316227749f, 0.0237137377f,
    0.0177827943f, 0.0133352149f, 0.00999999978f, 0.00749894185f, 0.00562341325f, 0.00421696482f, 0.00316227763f, 0.00237137359f, 0.00177827943f, 0.00133352145f, 0.00100000005f, 0.000749894243f, 0.000562341302f, 0.000421696517f,
    0.000316227757f, 0.00023713737f, 0.00017782794f, 0.00013335215f};
__device__ __forceinline__ void sincos_acc(float a, float& s, float& c) {
    const double ad = (double)a, k = __builtin_rint(ad * 0.63661977236758134308), r = __builtin_fma(-k, 1.57079632679489661923, ad);
    const float x = (float)r, x2 = x * x; const int q = (int)k & 3;
    const float sp = x + x * x2 * ((-1.9515295891e-4f * x2 + 8.3321608736e-3f) * x2 - 1.6666654611e-1f);
    const float cp = 1.0f - 0.5f * x2 + x2 * x2 * ((2.443315711809948e-5f * x2 - 1.388731625493765e-3f) * x2 + 4.166664568298827e-2f);
    s = (q == 0) ? sp : (q == 1) ? cp : (q == 2) ? -sp : -cp;
    c = (q == 0) ? cp : (q == 1) ? -sp : (q == 2) ? -cp : sp;
}
template <class F> __device__ __forceinline__ void tr_item64(const F& f, int K, bf16* WT, int kb, int nb, LAS unsigned* scr, int lane) {
    const int k0 = 64 * kb, n0 = 64 * nb, n4 = lane & 15, kq = lane >> 4;
    const int st = f.col(n0 + 4 * n4);
    f32x4 v[16];
#pragma unroll
    for (int i = 0; i < 16; ++i) v[i] = f.val4(k0 + 16 * kq + i, st);
#pragma unroll
    for (int j = 0; j < 4; ++j) {
        v4u a, b2;
        a.x = pk2(v[0][j], v[1][j]); a.y = pk2(v[2][j], v[3][j]); a.z = pk2(v[4][j], v[5][j]); a.w = pk2(v[6][j], v[7][j]);
        b2.x = pk2(v[8][j], v[9][j]); b2.y = pk2(v[10][j], v[11][j]); b2.z = pk2(v[12][j], v[13][j]); b2.w = pk2(v[14][j], v[15][j]);
        LAS v4u* p = (LAS v4u*)(scr + (4 * n4 + j) * 36 + 8 * kq);
        p[0] = a; p[1] = b2;
    }
    LDS_WAIT(); asm volatile("" ::: "memory");
#pragma unroll
    for (int r = 0; r < 8; ++r) { const int idx = lane + 64 * r, row = idx >> 3, ch = idx & 7;
        const v4u o = *(const LAS v4u*)(scr + row * 36 + 4 * ch);
        *(v4u*)(WT + (size_t)(n0 + row) * K + k0 + 8 * ch) = o; }
    LDS_WAIT(); asm volatile("" ::: "memory");
}
__host__ __device__ __forceinline__ int win_src(int n) {
    if (n < 384) return n;
    if (n < 416) return 640 + (n - 384);
    if (n < 512) return -1;
    if (n < 768) return 384 + (n - 512);
    if (n < 1792) { const int q = n - 768, region = q >> 9, qq = q & 511, c = qq >> 6, w = qq & 63, g = w >> 5, p = w & 31, f = 16 * g + (p & 15) + 32 * (p >> 4);
        return (region ? 1184 : 672) + 64 * c + f; }
    return 1696 + (n - 1792);
}
struct SrcWin { const float* w; const float* g; __device__ __forceinline__ int col(int n) const { return win_src(n); }
    __device__ __forceinline__ f32x4 val4(int k, int st) const { const f32x4 v = *(const f32x4*)(w + (size_t)k * IN_COLS + (st < 0 ? 0 : st)) * g[k]; return st < 0 ? f32x4{} : v; } };
struct SrcScaled { const float* w; const float* g; int N; __device__ __forceinline__ int col(int n) const { return n; }
    __device__ __forceinline__ f32x4 val4(int k, int st) const { return *(const f32x4*)(w + (size_t)k * N + st) * g[k]; } };
struct SrcPlain { const float* w; int N; __device__ __forceinline__ int col(int n) const { return n; }
    __device__ __forceinline__ f32x4 val4(int k, int st) const { return *(const f32x4*)(w + (size_t)k * N + st); } };
struct SrcGU { const float* wg; const float* wu; const float* g; __device__ __forceinline__ int col(int r) const { const int G = r >> 5, p = r & 31; return ((p >> 4) << 16) | (16 * G + (p & 15)); }
    __device__ __forceinline__ f32x4 val4(int k, int st) const { const unsigned long long d = (unsigned long long)wu - (unsigned long long)wg; const float* w = (const float*)((unsigned long long)wg + ((st >> 16) ? d : 0ull));
        return *(const f32x4*)(w + (size_t)k * DFF + (st & 0xffff)) * g[k]; } };

constexpr int I64_IN = 16 * 36, I64_UQ = 6 * 12, I64_UKV = 4 * 16, I64_O = 16 * 16, I64_GU1 = 16 * 8, I64_GU = NEXP * I64_GU1, I64_D1 = 4 * 16, I64_D = NEXP * I64_D1;
constexpr int I64_LATE = I64_UQ + I64_UKV + I64_O + I64_GU + I64_D;
__device__ __forceinline__ void late_weight_item(const In& I, unsigned char* ws, int r, LAS unsigned* scr, int lane) {
    bf16* Wuq_t = (bf16*)(ws + WS_WUQ); bf16* Wukv_t = (bf16*)(ws + WS_WUKV); bf16* Wo_t = (bf16*)(ws + WS_WO); bf16* Wgu_t = (bf16*)(ws + WS_WGU); bf16* Wd_t = (bf16*)(ws + WS_WD);
    if (r < I64_UQ) { SrcScaled f{I.w_uq, I.q_norm_g, 768}; tr_item64(f, QR, Wuq_t, r / 12, r % 12, scr, lane); return; } r -= I64_UQ;
    if (r < I64_UKV) { SrcScaled f{I.w_ukv, I.kv_norm_g, 1024}; tr_item64(f, KVR, Wukv_t, r / 16, r % 16, scr, lane); return; } r -= I64_UKV;
    if (r < I64_O) { SrcPlain f{I.w_o, 1024}; tr_item64(f, 1024, Wo_t, r / 16, r % 16, scr, lane); return; } r -= I64_O;
    if (r < I64_GU) { const int e = r / I64_GU1, q = r % I64_GU1; SrcGU f{I.w_gate + (size_t)e * DM * DFF, I.w_up + (size_t)e * DM * DFF, I.ffn_norm_g}; tr_item64(f, 1024, Wgu_t + (size_t)e * 512 * 1024, q / 8, q % 8, scr, lane); return; } r -= I64_GU;
    { const int e = r / I64_D1, q = r % I64_D1; SrcPlain f{I.w_down + (size_t)e * DFF * DM, 1024}; tr_item64(f, DFF, Wd_t + (size_t)e * 1024 * DFF, q / 16, q % 16, scr, lane); }
}

__device__ __forceinline__ void p0_prologue(const In& I, unsigned char* ws, LAS unsigned char* lds, int vcu, int G, int wave, int lane) {
    LAS unsigned* scr = (LAS unsigned*)(lds + RING_OFF + wave * 16384);
    const int gw = vcu * NWAVES + wave, NGW = G * NWAVES;
    bf16* Win_t = (bf16*)(ws + WS_WIN);
    for (int it = gw; it < I64_IN; it += NGW) { SrcWin f{I.w_in, I.attn_norm_g}; tr_item64(f, 1024, Win_t, it / 36, it % 36, scr, lane); }
    bf16* XB = (bf16*)(ws + WS_XB);
    for (int m = gw; m < T_TOK; m += NGW) {
        const f32x4* xr = (const f32x4*)(I.x + (size_t)m * DM) + lane;
        f32x4 v[4]; float s = 0.f;
#pragma unroll
        for (int j = 0; j < 4; ++j) { v[j] = xr[64 * j]; s += (v[j].x * v[j].x + v[j].y * v[j].y) + (v[j].z * v[j].z + v[j].w * v[j].w); }
        const float rs = 1.0f / sqrtf(wave_sum(s) * (1.0f / DM) + EPS);
        v2u* o8 = (v2u*)(XB + (size_t)m * DM) + lane;
#pragma unroll
        for (int j = 0; j < 4; ++j) { v2u w; w.x = pk2(v[j].x * rs, v[j].y * rs); w.y = pk2(v[j].z * rs, v[j].w * rs); o8[64 * j] = w; }
    }
    f32x2* cs = (f32x2*)(ws + WS_CS);
    for (int idx = gw * 64 + lane; idx < T_TOK * 32; idx += NGW * 64) {
        const int m = idx >> 5, i = idx & 31;
        const float ang = (float)I.positions[m] * INVF[i];
        float sn, cn; sincos_acc(ang, sn, cn); f32x2 c; c.x = cn; c.y = sn; cs[idx] = c;
    }
    bf16* wrh = (bf16*)(ws + WS_WR); bf16* wrl = wrh + 48 * 1024;
    for (int idx = gw * 64 + lane; idx < 48 * 1024; idx += NGW * 64) {
        const int j = idx >> 10, k = idx & 1023;
        float w = j < 4 ? I.w_rg[k * 4 + j] : (j < 36 ? I.w_re[k * 32 + (j - 4)] : 0.f);
        w *= I.ffn_norm_g[k];
        const unsigned h = f2bf(w); wrh[idx] = (bf16)h; wrl[idx] = (bf16)f2bf(w - bf2f(h));
    }
}

constexpr int RT_PART = 2048, RT_STRIDE = 49, RT_SSQ = RT_PART + 8 * 64 * RT_STRIDE * 4;
static_assert(RT_SSQ + 8 * 64 * 4 <= RING_BYTES, "router LDS");
__device__ __forceinline__ void route_phase(const In& I, const bf16* HB, unsigned char* ws, LAS unsigned char* lds, int vcu, int G, int wave, int lane) {
    LAS unsigned* cnt_l = (LAS unsigned*)(lds + 0); LAS unsigned* base_l = (LAS unsigned*)(lds + 128);
    LAS float* part = (LAS float*)(lds + RT_PART); LAS float* pssq = (LAS float*)(lds + RT_SSQ);
    const bf16* wrh = (const bf16*)(ws + WS_WR); const bf16* wrl = wrh + 48 * 1024;
    unsigned* gcnt = (unsigned*)(ws + WS_CTL) + CW_CNT;
    v4u* rec = (v4u*)(ws + WS_REC); int* TOK = (int*)(ws + WS_TOK); float* GWT = (float*)(ws + WS_GWT); float* RST = (float*)(ws + WS_RST);
    const int tid = wave * 64 + lane, rl = lane & 15, kg = lane >> 4, k0 = 128 * wave + 8 * kg;
    bf16x8 bh[3][4], bl[3][4];
#pragma unroll
    for (int cb = 0; cb < 3; ++cb)
#pragma unroll
        for (int s = 0; s < 4; ++s) { bh[cb][s] = *(const bf16x8*)(wrh + (size_t)(16 * cb + rl) * 1024 + k0 + 32 * s); bl[cb][s] = *(const bf16x8*)(wrl + (size_t)(16 * cb + rl) * 1024 + k0 + 32 * s); }
    for (int grp = vcu; grp < T_TOK / 64; grp += G) {
        const int m0 = 64 * grp;
        if (tid < 32) cnt_l[tid] = 0u;
#pragma unroll 1
        for (int gp = 0; gp < 2; ++gp) {
            bf16x8 a[2][4];
#pragma unroll
            for (int g = 0; g < 2; ++g)
#pragma unroll
                for (int s = 0; s < 4; ++s) a[g][s] = *(const bf16x8*)(HB + (size_t)(m0 + 32 * gp + 16 * g + rl) * DM + k0 + 32 * s);
#pragma unroll
            for (int g = 0; g < 2; ++g) {
                float ss = 0.f; f32x4 acc[3]; acc[0] = f32x4{}; acc[1] = f32x4{}; acc[2] = f32x4{};
#pragma unroll
                for (int s = 0; s < 4; ++s) {
                    const v4u w = __builtin_bit_cast(v4u, a[g][s]);
#pragma unroll
                    for (int j = 0; j < 4; ++j) { const float x0 = bf2f(w[j] & 0xffffu), x1 = bf2f(w[j] >> 16); ss += x0 * x0 + x1 * x1; }
#pragma unroll
                    for (int cb = 0; cb < 3; ++cb) { acc[cb] = __builtin_amdgcn_mfma_f32_16x16x32_bf16(a[g][s], bh[cb][s], acc[cb], 0, 0, 0); acc[cb] = __builtin_amdgcn_mfma_f32_16x16x32_bf16(a[g][s], bl[cb][s], acc[cb], 0, 0, 0); }
                }
                ss += __shfl_xor(ss, 16); ss += __shfl_xor(ss, 32);
                const int tg = 32 * gp + 16 * g;
                if (kg == 0) pssq[wave * 64 + tg + rl] = ss;
#pragma unroll
                for (int cb = 0; cb < 3; ++cb)
#pragma unroll
                    for (int r = 0; r < 4; ++r) part[(wave * 64 + tg + 4 * kg + r) * RT_STRIDE + 16 * cb + rl] = acc[cb][r];
            }
        }
        __syncthreads();
        int e0 = 0, e1 = 0; float w0 = 0.f, w1 = 0.f, rstd = 0.f; unsigned lr0 = 0, lr1 = 0;
        if (wave == 0) {
            float L[36]; float ssq = 0.f;
#pragma unroll
            for (int j = 0; j < 36; ++j) L[j] = 0.f;
#pragma unroll 1
            for (int w = 0; w < 8; ++w) { ssq += pssq[w * 64 + lane];
#pragma unroll
                for (int j = 0; j < 36; ++j) L[j] += part[(w * 64 + lane) * RT_STRIDE + j]; }
            rstd = 1.0f / sqrtf(ssq * (1.0f / DM) + EPS);
            float gl[4];
#pragma unroll
            for (int g = 0; g < 4; ++g) gl[g] = L[g] * rstd + I.b_rg[g];
            int gi = 0; float gm = gl[0];
#pragma unroll
            for (int g = 1; g < 4; ++g) if (gl[g] > gm) { gm = gl[g]; gi = g; }
            float ps = 0.f;
#pragma unroll
            for (int g = 0; g < 4; ++g) ps += __expf(gl[g] - gm);
            const float pg = 1.0f / ps;
            float el[8];
#pragma unroll
            for (int e = 0; e < 8; ++e) { const float raw = gi == 0 ? L[4 + e] : gi == 1 ? L[12 + e] : gi == 2 ? L[20 + e] : L[28 + e]; el[e] = raw * rstd + I.b_re[8 * gi + e]; }
            int i1 = 0; float l1 = el[0];
#pragma unroll
            for (int e = 1; e < 8; ++e) if (el[e] > l1) { l1 = el[e]; i1 = e; }
            int i2 = 0; float l2 = -INFINITY;
#pragma unroll
            for (int e = 0; e < 8; ++e) if (e != i1 && el[e] > l2) { l2 = el[e]; i2 = e; }
            const float ex = __expf(l2 - l1), wn1 = 1.0f / (1.0f + ex), wn2 = ex * wn1;
            e0 = 8 * gi + i1; e1 = 8 * gi + i2; w0 = pg * wn1; w1 = pg * wn2;
            lr0 = __hip_atomic_fetch_add(cnt_l + e0, 1u, __ATOMIC_RELAXED, __HIP_MEMORY_SCOPE_WORKGROUP);
            lr1 = __hip_atomic_fetch_add(cnt_l + e1, 1u, __ATOMIC_RELAXED, __HIP_MEMORY_SCOPE_WORKGROUP);
        }
        __syncthreads();
        if (tid < 32) { const unsigned c = cnt_l[tid]; base_l[tid] = c ? __hip_atomic_fetch_add(gcnt + tid, c, __ATOMIC_RELAXED, __HIP_MEMORY_SCOPE_AGENT) : 0u; }
        __syncthreads();
        if (wave == 0) {
            const unsigned k0r = (base_l[e0] + lr0) & 16383u, k1r = (base_l[e1] + lr1) & 16383u; const int m = m0 + lane;
            v4u r; r.x = (unsigned)e0 | ((unsigned)e1 << 8); r.y = k0r; r.z = k1r; r.w = 0u; rec[m] = r;
            TOK[e0 * 16384 + k0r] = m; GWT[e0 * 16384 + k0r] = w0; RST[e0 * 16384 + k0r] = rstd;
            TOK[e1 * 16384 + k1r] = m; GWT[e1 * 16384 + k1r] = w1; RST[e1 * 16384 + k1r] = rstd;
        }
        __syncthreads();
    }
}

constexpr int MT_PEXP = LDSCTL_OFF + 1024, MT_PBASE = MT_PEXP + 1024, MT_CNT = MT_PBASE + 128, MT_TOKL = LDSCTL_OFF + 4096;
static_assert(MT_TOKL + 3 * 1024 <= LDS_BYTES, "moe LDS");
__device__ __forceinline__ void moe_tables(const unsigned char* ws, LAS unsigned char* ldsall, int wave, int lane) {
    __syncthreads();
    if (wave == 0) {
        const unsigned* gcnt = (const unsigned*)(ws + WS_CTL) + CW_CNT;
        LAS int* pexp = (LAS int*)(ldsall + MT_PEXP); LAS int* pbase = (LAS int*)(ldsall + MT_PBASE); LAS int* cntl = (LAS int*)(ldsall + MT_CNT);
        const unsigned c = lane < 32 ? __hip_atomic_load(gcnt + (lane & 31), RLX_AGENT) : 0u; const unsigned np = (c + 255u) >> 8;
        unsigned incl = np;
#pragma unroll
        for (int o = 1; o < 32; o <<= 1) { const unsigned t = __shfl_up(incl, o); if ((lane & 31) >= o) incl += t; }
        if (lane < 32) { const unsigned pb = incl - np; pbase[lane] = (int)pb; cntl[lane] = (int)c; for (unsigned p = 0; p < np; ++p) if (pb + p < (unsigned)MAXPANEL) pexp[pb + p] = lane; }
        if (lane == 31) pexp[MAXPANEL] = (int)(incl < (unsigned)MAXPANEL ? incl : (unsigned)MAXPANEL);
    }
    __syncthreads();
}

__device__ __forceinline__ void final_phase(const In& I, const bf16* HB, float* out, const unsigned char* ws, LAS unsigned char* ldsall, int vcu, int G, int wave, int lane, float oscale) {
    const v4u* rec = (const v4u*)(ws + WS_REC); const bf16* Y = (const bf16*)(ws + WS_TS);
    const LAS int* pbase = (const LAS int*)(ldsall + MT_PBASE);
    const int pb = pbase[lane & 31] * 256;
    const f32x4* gr = (const f32x4*)I.final_g;
    const f32x4 g0 = gr[2 * lane], g1 = gr[2 * lane + 1], g2 = gr[128 + 2 * lane], g3 = gr[128 + 2 * lane + 1];
    const int gw = vcu * NWAVES + wave, NGW = G * NWAVES;
    for (int mb = 4 * gw; mb < T_TOK; mb += 4 * NGW) {
        const v4u rv = rec[mb + (lane & 3)];
        v4u h[4][2], ya[4][2], yb[4][2];
#pragma unroll
        for (int q = 0; q < 4; ++q) {
            const unsigned ee = __shfl(rv.x, q), k0r = __shfl(rv.y, q), k1r = __shfl(rv.z, q);
            unsigned s0 = (unsigned)__shfl(pb, ee & 31u) + k0r, s1 = (unsigned)__shfl(pb, (ee >> 8) & 31u) + k1r;
            s0 = s0 < (unsigned)MAXSLOT ? s0 : MAXSLOT - 1; s1 = s1 < (unsigned)MAXSLOT ? s1 : MAXSLOT - 1;
            const v4u* hp = (const v4u*)(HB + (size_t)(mb + q) * DM) + lane; const v4u* p0 = (const v4u*)(Y + (size_t)s0 * DM) + lane; const v4u* p1 = (const v4u*)(Y + (size_t)s1 * DM) + lane;
            h[q][0] = hp[0]; h[q][1] = hp[64]; ya[q][0] = p0[0]; ya[q][1] = p0[64]; yb[q][0] = p1[0]; yb[q][1] = p1[64];
        }
#pragma unroll
        for (int q = 0; q < 4; ++q) {
            f32x4 v[4]; float s = 0.f;
#pragma unroll
            for (int hf = 0; hf < 2; ++hf)
#pragma unroll
                for (int j = 0; j < 4; ++j) { const unsigned a = h[q][hf][j], b = ya[q][hf][j], c = yb[q][hf][j];
                    const float x0 = bf2f(a & 0xffffu) + bf2f(b & 0xffffu) + bf2f(c & 0xffffu), x1 = bf2f(a >> 16) + bf2f(b >> 16) + bf2f(c >> 16);
                    v[2 * hf + (j >> 1)][2 * (j & 1)] = x0; v[2 * hf + (j >> 1)][2 * (j & 1) + 1] = x1; s += x0 * x0 + x1 * x1; }
            const float rs = oscale / sqrtf(wave_sum(s) * (1.0f / DM) + EPS);
            f32x4* op = (f32x4*)(out + (size_t)(mb + q) * DM);
            op[2 * lane] = v[0] * rs * g0; op[2 * lane + 1] = v[1] * rs * g1; op[128 + 2 * lane] = v[2] * rs * g2; op[128 + 2 * lane + 1] = v[3] * rs * g3;
        }
    }
}

__global__ void __launch_bounds__(NWAVES * 64, 2) fwd_kernel(Args args) {
    extern __shared__ __attribute__((aligned(16))) unsigned char lds_raw[];
    LAS unsigned char* lds = (LAS unsigned char*)lds_raw;
    volatile LAS unsigned* MISC = (volatile LAS unsigned*)(lds + MISC_OFF);
    const int tid = threadIdx.x, lane = tid & 63, wave = __builtin_amdgcn_readfirstlane(tid >> 6);
    const int G = gridDim.x; const int bx = blockIdx.x; const int vcu = (G % 8 == 0) ? (bx % 8) * (G / 8) + bx / 8 : bx;
    unsigned char* ws = args.ws; const In& I = args.in;
    gu32* ctl = (gu32*)(ws + WS_CTL);
    for (int u = tid; u < (LDS_BYTES - LDSCTL_OFF) / 4; u += NWAVES * 64) ((LAS unsigned*)(lds + LDSCTL_OFF))[u] = 0u;
    __syncthreads();
    XcdBarrier bar; bar.bar = (unsigned*)(ctl + CW_BAR); bar.x = 0; bar.st = nullptr;
    if (N_LAUNCHES != PER_PHASE) bar = xcd_barrier_post((unsigned*)(ctl + CW_BAR), MISC + 8);
    unsigned long long* stamps = (unsigned long long*)(ws + WS_CTL) + CW_STAMP / 2; int n_stamp = 0;
    if (PROBE_PHASE >= 0 && bx == 0 && tid == 0) stamps[0] = __builtin_amdgcn_s_memrealtime();
#define GRID_BAR() do { if (N_LAUNCHES == PER_PHASE) { if (tid == 0) __hip_atomic_store(ctl + CW_TMO, 0xBADBA0u, RLX_AGENT); } else { xcd_barrier(bar); } \
    if (PROBE_PHASE >= 0) { ++n_stamp; if (bx == 0 && tid == 0) stamps[n_stamp] = __builtin_amdgcn_s_memrealtime(); } } while (0)
    const int lo = args.ph_lo, hi = args.ph_hi;
#ifndef PHMASK
#define PHMASK 0x3ff
#endif
#define IN(k) (((PHMASK >> (k)) & 1) && lo <= (k) && (k) < hi)
#define NEXTP(k) ((k) == 5 ? 7 : (k) + 1)
#define BOTH(k) (IN(k) && IN(NEXTP(k)))

    if (IN(0)) { for (int rep = 0; rep < 1 + ((REPEAT_MASK >> 0) & 1); ++rep) { p0_prologue(I, ws, lds, vcu, G, wave, lane); __syncthreads(); } if (BOTH(0)) GRID_BAR(); }

    if (IN(1)) {
        pg8::Gemm g{(const pg8::bf16_t*)(ws + WS_XB), (const pg8::bf16_t*)(ws + WS_WIN), T_TOK, NPROJ, DM};
        pg8::StaticOrder S; S.init(T_TOK, NPROJ, G, bx);
        pg8::EpiProj E{(unsigned long long*)(ctl + CW_SSQQ), (unsigned long long*)(ctl + CW_SSQKV), (const pg8::f32x2e*)(ws + WS_CS), (pg8::bf16_t*)(ws + WS_CQ), (pg8::bf16_t*)(ws + WS_CKV), ws + WS_KM, (pg8::bf16_t*)(ws + WS_DQ), ws + WS_DKI, ws + WS_DVI};
        pg8::gemm_phase<pg8::EpiProj, pg8::StaticOrder, true, true>(lds + RING_OFF, g, S, E);
        { const int nfull = (576 % G) ? (576 % G) : G;
          if (bx >= nfull) { LAS unsigned* scr = (LAS unsigned*)(lds + RING_OFF + wave * 16384); const int nh = (G - nfull) * NWAVES;
              for (int it = (bx - nfull) * NWAVES + wave; it < I64_LATE; it += nh) late_weight_item(I, ws, it, scr, lane); }
          else if (nfull == G) { LAS unsigned* scr = (LAS unsigned*)(lds + RING_OFF + wave * 16384); for (int it = bx * NWAVES + wave; it < I64_LATE; it += G * NWAVES) late_weight_item(I, ws, it, scr, lane); } }
        if (BOTH(1)) GRID_BAR();
    }

    if (IN(2)) {
#ifndef NO_Q
        { pg8::Gemm g{(const pg8::bf16_t*)(ws + WS_CQ), (const pg8::bf16_t*)(ws + WS_WUQ), T_TOK, 768, QR};
          pg8::StaticOrder S; S.init(T_TOK, 768, G, bx);
          pg8::EpiMlaQ E{(const unsigned long long*)(ctl + CW_SSQQ), (const pg8::f32x2e*)(ws + WS_CS), (pg8::bf16_t*)(ws + WS_QM)};
          pg8::gemm_phase<pg8::EpiMlaQ, pg8::StaticOrder, true, true>(lds + RING_OFF, g, S, E); }
#endif
        __syncthreads();
#ifndef NO_KV
        { pg8::Gemm g{(const pg8::bf16_t*)(ws + WS_CKV), (const pg8::bf16_t*)(ws + WS_WUKV), T_TOK, 1024, KVR};
          pg8::StaticOrder S; S.init(T_TOK, 1024, G, (bx + 192) % G);
          pg8::EpiMlaKV E{(const unsigned long long*)(ctl + CW_SSQKV), ws + WS_KM, ws + WS_VM};
          pg8::gemm_phase<pg8::EpiMlaKV, pg8::StaticOrder, true, true>(lds + RING_OFF, g, S, E); }
#endif
        if (BOTH(2)) GRID_BAR();
    }

    if (IN(3)) {
        float lam;
        { const float a = I.lq1[lane] * I.lk1[lane], b = I.lq2[lane] * I.lk2[lane]; lam = expf(wave_sum(a)) - expf(wave_sum(b)) + LAM_INIT; }
        att::AttnArgs A{(const bf16*)(ws + WS_QM), ws + WS_KM, ws + WS_VM, (const bf16*)(ws + WS_DQ), ws + WS_DKI, ws + WS_DVI, (bf16*)(ws + WS_ATT), I.subln_g, lam};
        __syncthreads();
        att::attn_phase(A, lds + RING_OFF, vcu, G, wave, lane);
        if (BOTH(3)) GRID_BAR();
    }

    if (IN(4)) {
        pg8::Gemm g{(const pg8::bf16_t*)(ws + WS_ATT), (const pg8::bf16_t*)(ws + WS_WO), T_TOK, DM, DM};
        pg8::StaticOrder S; S.init(T_TOK, DM, G, bx);
        pg8::EpiWo E{I.x, (pg8::bf16_t*)(ws + WS_HB)};
        pg8::gemm_phase<pg8::EpiWo, pg8::StaticOrder, true, true>(lds + RING_OFF, g, S, E);
        if (BOTH(4)) GRID_BAR();
    }

    if (IN(5)) { __syncthreads(); route_phase(I, (const bf16*)(ws + WS_HB), ws, lds + RING_OFF, vcu, G, wave, lane); if (BOTH(5)) GRID_BAR(); }

    if (IN(7)) {
        moe_tables(ws, lds, wave, lane);
        LAS int* tokl = (LAS int*)(lds + MT_TOKL);
        pg8::MoeOrder S; S.init((const LAS int*)(lds + MT_PEXP), tokl, 2, G, bx);
        { const int* TOK = (const int*)(ws + WS_TOK); const LAS int* pbase = (const LAS int*)(lds + MT_PBASE); const LAS int* cntl = (const LAS int*)(lds + MT_CNT);
          for (int i = 0; i < 3; ++i) { pg8::Unit u; if (!S.next(i, u)) break; const int e = u.pn >> 1, j = u.pm - pbase[e];
              if (tid < 256) { const int rank = 256 * j + tid; tokl[256 * i + tid] = TOK[e * 16384 + (rank < cntl[e] ? rank : 0)] & 16383; } } }
        __syncthreads();
        pg8::Gemm g{(const pg8::bf16_t*)(ws + WS_HB), (const pg8::bf16_t*)(ws + WS_WGU), MAXSLOT, NEXP * 512, DM};
        pg8::EpiGateUp E{(const float*)(ws + WS_GWT), (const float*)(ws + WS_RST), (const LAS int*)(lds + MT_PBASE), (pg8::bf16_t*)(ws + WS_HDN)};
        pg8::gemm_phase<pg8::EpiGateUp, pg8::MoeOrder, true, true, true>(lds + RING_OFF, g, S, E);
        if (BOTH(7)) GRID_BAR();
    }

    if (IN(8)) {
        moe_tables(ws, lds, wave, lane);
        pg8::Gemm g{(const pg8::bf16_t*)(ws + WS_HDN), (const pg8::bf16_t*)(ws + WS_WD), MAXSLOT, NEXP * 1024, DFF};
        pg8::MoeOrder S; S.init((const LAS int*)(lds + MT_PEXP), (const LAS int*)(lds + MT_TOKL), 4, G, bx);
        pg8::EpiDown E{(pg8::bf16_t*)(ws + WS_TS)};
        for (int rep = 0; rep < 1 + ((REPEAT_MASK >> 8) & 1); ++rep) { pg8::gemm_phase<pg8::EpiDown, pg8::MoeOrder, true, true>(lds + RING_OFF, g, S, E); __syncthreads(); }
        if (BOTH(8)) GRID_BAR();
    }

    if (IN(9)) {
        float oscale = 1.0f;
        if (PROBE_PHASE >= 0) { const unsigned long long dt = stamps[PROBE_PHASE + 1] - stamps[PROBE_PHASE]; float fr = (float)dt * (1.0f / 50000.0f); fr = fr > 1.f ? 1.f : fr; oscale = 1.0f + sqrtf(2e-3f * fr); }
        moe_tables(ws, lds, wave, lane);
        final_phase(I, (const bf16*)(ws + WS_HB), args.out, ws, lds, vcu, G, wave, lane, oscale);
    }
#undef IN
#undef BOTH
#undef GRID_BAR
}

extern "C" void kernel_launch(void* const* d_in, const int* in_sizes, int n_in, void* d_out, int out_size, void* d_ws, size_t ws_size, hipStream_t stream) {
    static int grid = 0;
    if (grid == 0) {
        if (n_in != 23 || in_sizes[0] != T_TOK * DM || out_size != T_TOK * DM || ws_size < WS_END) { fprintf(stderr, "kernel_launch: unexpected problem shape (n_in %d, in0 %d, out %d, ws %zu)\n", n_in, n_in > 0 ? in_sizes[0] : -1, out_size, ws_size); grid = -1; return; }
        int dev = 0, cus = 0, per_cu = 0;
        if (hipGetDevice(&dev) != hipSuccess || hipDeviceGetAttribute(&cus, hipDeviceAttributeMultiprocessorCount, dev) != hipSuccess) { grid = -1; return; }
        if (hipFuncSetAttribute((const void*)fwd_kernel, hipFuncAttributeMaxDynamicSharedMemorySize, LDS_BYTES) != hipSuccess) { fprintf(stderr, "kernel_launch: hipFuncSetAttribute failed\n"); grid = -1; return; }
        if (hipOccupancyMaxActiveBlocksPerMultiprocessor(&per_cu, (const void*)fwd_kernel, NWAVES * 64, LDS_BYTES) != hipSuccess || per_cu < 1) { fprintf(stderr, "kernel_launch: occupancy query says %d blocks per CU\n", per_cu); }
        (void)hipGetLastError();
        grid = cus;
    }
    if (grid < 0) return;
    if (hipMemsetAsync((char*)d_ws + WS_CTL, 0, CTL_ZERO_BYTES, stream) != hipSuccess) { fprintf(stderr, "kernel_launch: memset failed\n"); return; }
    Args a{};
    const void** ip = (const void**)&a.in;
    for (int i = 0; i < 23; ++i) ip[i] = d_in[i];
    a.out = (float*)d_out; a.ws = (unsigned char*)d_ws;
    if (N_LAUNCHES == 1) {
        a.ph_lo = 0; a.ph_hi = PER_PHASE; a.li = 0;
        hipLaunchKernelGGL(fwd_kernel, dim3(grid), dim3(NWAVES * 64), LDS_BYTES, stream, a);
    } else {
        for (int li = 0; li < PER_PHASE; ++li) { a.ph_lo = li; a.ph_hi = li + 1; a.li = li; hipLaunchKernelGGL(fwd_kernel, dim3(grid), dim3(NWAVES * 64), LDS_BYTES, stream, a); }
    }
    const hipError_t le = hipPeekAtLastError();
    if (le != hipSuccess) fprintf(stderr, "kernel_launch: launch failed: %s\n", hipGetErrorName(le));
}
```

```cpp
#include <hip/hip_runtime.h>
#include <cstdio>
#include <cstdint>

#ifndef PROBE_PHASE
#define PROBE_PHASE -1
#endif
#ifndef PROBE_TICKS
#define PROBE_TICKS 50000.0f
#endif
#ifndef ATT_VAR
#define ATT_VAR 0
#endif
#ifndef REPEAT_MASK
#define REPEAT_MASK 0
#endif
#ifndef MK_N_LAUNCHES
#define MK_N_LAUNCHES 1
#endif

constexpr int NB = 8, SEQ = 2048, DM = 1024, T_TOK = NB * SEQ;
constexpr int IN_COLS = 2208, NPROJ = 2304;
constexpr int QR = 384, KVR = 256;
constexpr int NEXP = 32, DFF = 256;
constexpr int MAXPANEL = 160, MAXSLOT = MAXPANEL * 256;
constexpr float EPS = 1e-6f;
constexpr float LOG2E = 1.4426950408889634f;
constexpr float QSCALE_M = 0.10206207261596577f * LOG2E;
constexpr float QSCALE_D = 0.125f * LOG2E;
constexpr float LAM_INIT = 0.2f;

constexpr size_t MiB = 1u << 20;
constexpr size_t WS_CTL = 0, CTL_BYTES = 1 * MiB, CTL_ZERO_BYTES = 64 * 1024;
constexpr size_t WS_WIN = 1 * MiB;
constexpr size_t WS_WUQ = 6 * MiB;
constexpr size_t WS_WUKV = 7 * MiB;
constexpr size_t WS_WO = 8 * MiB;
constexpr size_t WS_WGU = 10 * MiB;
constexpr size_t WS_WD = 42 * MiB;
constexpr size_t WS_CS = 58 * MiB;
constexpr size_t WS_WR = 62 * MiB;
constexpr size_t WS_REC = 62 * MiB + 256 * 1024;
constexpr size_t WS_GW = 63 * MiB;
constexpr size_t WS_PEXP = 63 * MiB + 256 * 1024;
constexpr size_t WS_XB = 64 * MiB;
constexpr size_t WS_ATT = WS_XB;
constexpr size_t WS_CQ = 96 * MiB;
constexpr size_t WS_CKV = 108 * MiB;
constexpr size_t WS_QM = 116 * MiB;
constexpr size_t WS_KM = 140 * MiB;
constexpr size_t WS_VM = 164 * MiB;
constexpr size_t WS_DQ = 180 * MiB;
constexpr size_t WS_DKI = 196 * MiB;
constexpr size_t WS_DVI = 212 * MiB;
constexpr size_t WS_TS = 96 * MiB;
constexpr size_t WS_HB = 196 * MiB;
constexpr size_t WS_TOK = 64 * MiB;
constexpr size_t WS_GWT = 66 * MiB, WS_RST = 68 * MiB;
constexpr size_t WS_HDN = 176 * MiB;
constexpr size_t WS_END = 228 * MiB;
constexpr int CW_TMO = 0;
constexpr int CW_BAR = 4096;
constexpr int CW_STAMP = 12288;
constexpr int CW_CNT = 8192;
constexpr int CW_SSQQ = 16384;
constexpr int CW_SSQKV = 49152;
static_assert((CW_SSQKV + 32768) * 4 <= (int)CTL_BYTES && (CW_STAMP + 64) * 4 <= (int)CTL_ZERO_BYTES && CW_SSQQ * 4 >= (int)CTL_ZERO_BYTES, "ctl");

constexpr int RING_OFF = 0, RING_BYTES = 131072;
constexpr int LDSCTL_OFF = RING_BYTES, MISC_OFF = LDSCTL_OFF + 320;
constexpr int LDS_BYTES = 147456;

#define GAS __attribute__((address_space(1)))
#define LAS __attribute__((address_space(3)))
typedef unsigned short bf16;
typedef unsigned v4u __attribute__((ext_vector_type(4)));
typedef unsigned v2u __attribute__((ext_vector_type(2)));
typedef float f32x4 __attribute__((ext_vector_type(4)));
typedef float f32x2 __attribute__((ext_vector_type(2)));
typedef float f32x16 __attribute__((ext_vector_type(16)));
typedef short bf16x8 __attribute__((ext_vector_type(8)));
typedef short s16x4 __attribute__((ext_vector_type(4)));
typedef GAS unsigned gu32;
#define RLX_AGENT __ATOMIC_RELAXED, __HIP_MEMORY_SCOPE_AGENT
#define LDS_WAIT() asm volatile("s_waitcnt lgkmcnt(0)" ::: "memory")
#define VM_WAIT() asm volatile("s_waitcnt vmcnt(0)" ::: "memory")
__device__ __forceinline__ unsigned f2bf(float f) { unsigned u = __builtin_bit_cast(unsigned, f); return (u + 0x7fffu + ((u >> 16) & 1u)) >> 16; }
__device__ __forceinline__ unsigned pk2(float lo, float hi) { return f2bf(lo) | (f2bf(hi) << 16); }
__device__ __forceinline__ float bf2f(unsigned b) { return __builtin_bit_cast(float, b << 16); }
typedef __bf16 bf16x2_t __attribute__((ext_vector_type(2)));
__device__ __forceinline__ unsigned cvtpk(float lo, float hi) { f32x2 v = {lo, hi}; bf16x2_t b = __builtin_convertvector(v, bf16x2_t); return __builtin_bit_cast(unsigned, b); }
__device__ __forceinline__ v2u pack4(f32x4 v) { v2u r; r.x = cvtpk(v[0], v[1]); r.y = cvtpk(v[2], v[3]); return r; }
__device__ __forceinline__ float wave_sum(float v) {
#pragma unroll
    for (int o = 1; o < 64; o <<= 1) v += __shfl_xor(v, o);
    return v;
}

#define XB_TMO      128
#define XB_XCNT(j)  (256  + 64 * (j))
#define XB_XSUB(j)  (1280 + 64 * (j))
#define XB_XGEN(j)  (2304 + 64 * (j))
#define XB_TOP      3328
#define XB_TOPGEN   3392
#define XCD_BAR_WORDS 3456
#define XB_SPIN_CAP (1u << 18)
__device__ __forceinline__ unsigned xb_ld(unsigned* p)              { return __hip_atomic_load(p, __ATOMIC_RELAXED, __HIP_MEMORY_SCOPE_AGENT); }
__device__ __forceinline__ unsigned xb_add(unsigned* p, unsigned v) { return __hip_atomic_fetch_add(p, v, __ATOMIC_RELAXED, __HIP_MEMORY_SCOPE_AGENT); }
__device__ __forceinline__ unsigned xb_xcc_id() { return (unsigned)__builtin_amdgcn_s_getreg((3 << 11) | 20) & 0xFu; }
#define XB_SPIN(cond, bar) do { unsigned _sp = 0; while (cond) { __builtin_amdgcn_s_sleep(1); \
    if ((++_sp & 255u) == 0u) { if (xb_ld(&(bar)[XB_TMO])) break; if (_sp > XB_SPIN_CAP) { atomicAdd(&(bar)[XB_TMO], 1u); break; } } } } while (0)
struct XcdBarrier { unsigned* bar; unsigned x; volatile LAS unsigned* st; };
__device__ __forceinline__ XcdBarrier xcd_barrier_post(unsigned* bar, volatile LAS unsigned* st) {
    XcdBarrier b; b.bar = bar; b.x = xb_xcc_id(); b.st = st;
    if (threadIdx.x == 0) (void)xb_add(&bar[XB_XCNT(b.x)], 1u);
    return b;
}
__device__ __forceinline__ void xcd_barrier_complete(unsigned* bar, unsigned x, unsigned& nloc, unsigned& nx) {
    const unsigned G = gridDim.x * gridDim.y * gridDim.z;
    unsigned sum, cnt, mine, sp = 0u;
    for (;;) {
        sum = 0u; cnt = 0u; mine = 0u;
#pragma unroll
        for (unsigned j = 0; j < 16; ++j) { const unsigned c = xb_ld(&bar[XB_XCNT(j)]); sum += c; cnt += (c > 0u) ? 1u : 0u; mine = (j == x) ? c : mine; }
        if (sum == G) break;
        __builtin_amdgcn_s_sleep(1);
        if ((++sp & 255u) == 0u) { if (xb_ld(&bar[XB_TMO])) break; if (sp > XB_SPIN_CAP) { atomicAdd(&bar[XB_TMO], 1u); break; } }
    }
    nloc = mine > 0u ? mine : 1u; nx = cnt > 0u ? cnt : 1u;
}
__device__ __forceinline__ void xcd_barrier(const XcdBarrier& b) {
    asm volatile("s_waitcnt vmcnt(0)" ::: "memory");
    __syncthreads();
    if (threadIdx.x == 0) {
        unsigned* bar = b.bar;
        __builtin_amdgcn_s_waitcnt(0);
        unsigned nloc = b.st[0], nx = b.st[1];
        if (nloc == 0u) { xcd_barrier_complete(bar, b.x, nloc, nx); b.st[0] = nloc; b.st[1] = nx; }
        const unsigned old = xb_add(&bar[XB_XSUB(b.x)], 1u);
        const unsigned gen = old / nloc;
        if (old + 1u == (gen + 1u) * nloc) {
            __builtin_amdgcn_fence(__ATOMIC_RELEASE, "agent");
            asm volatile("s_waitcnt vmcnt(0)" ::: "memory");
            const unsigned og = xb_add(&bar[XB_TOP], 1u);
            const unsigned tg = og / nx;
            if (og + 1u == (tg + 1u) * nx) xb_add(&bar[XB_TOPGEN], 1u);
            else XB_SPIN(xb_ld(&bar[XB_TOPGEN]) == tg, bar);
            __builtin_amdgcn_fence(__ATOMIC_ACQUIRE, "agent");
            xb_add(&bar[XB_XGEN(b.x)], 1u);
            asm volatile("s_waitcnt vmcnt(0)" ::: "memory");
        } else {
            XB_SPIN(xb_ld(&bar[XB_XGEN(b.x)]) == gen, bar);
            __builtin_amdgcn_fence(__ATOMIC_ACQUIRE, "agent");
            asm volatile("s_waitcnt vmcnt(0)" ::: "memory");
        }
    }
    __syncthreads();
}
namespace pg8 {
#define PG8_LAS __attribute__((address_space(3)))
typedef unsigned short bf16_t;
typedef short bf16x8 __attribute__((ext_vector_type(8)));
typedef float f32x4 __attribute__((ext_vector_type(4)));
typedef unsigned u32x4 __attribute__((ext_vector_type(4)));
constexpr int BM = 256, BK = 64, HALF = 128, HTB = HALF * BK * 2  , STAGE_BYTES = 8 * HTB, NXCD = 8, WGM = 8;

__host__ __device__ __forceinline__ int lds_byte(int r, int c) { const int st = (r >> 4) * 2 + (c >> 5), rr = r & 15, cc = c & 31, ob = rr * 64 + cc * 2; return st * 1024 + (ob ^ (((ob >> 9) & 1) << 5)); }
__host__ __device__ __forceinline__ void stage_rc(int b, int& R, int& C) { const int st = b / 1024, sb = b % 1024, swz = sb ^ (((sb >> 9) & 1) << 5); R = (st >> 1) * 16 + swz / 64; C = (st & 1) * 32 + (swz % 64) / 2; }
__host__ __device__ __forceinline__ int perm32(int rho) { const int n = rho >> 4, i = rho & 15; return 8 * (i >> 2) + 4 * n + (i & 3); }

struct Unit { int pm, pn; };
struct Gemm { const bf16_t* A; const bf16_t* Bt; int M, N, K; };

struct StaticOrder {
    int nM, nN, nwg, G, c;
    __host__ __device__ void init(int M, int N, int G_, int c_) { nM = M / BM; nN = N / BM; nwg = nM * nN; G = G_; c = c_; }
    __host__ __device__ bool next(int i, Unit& u) const {
        const long L = (long)i * G + c; if (L >= nwg) return false;
        int wgid = (int)L; { const int q = nwg / NXCD, r = nwg % NXCD, xcd = wgid % NXCD, off = wgid / NXCD; wgid = (xcd < r ? xcd * (q + 1) : r * (q + 1) + (xcd - r) * q) + off; }
        const int nig = WGM * nN, gid = wgid / nig, fm = gid * WGM, gsz = (nM - fm) < WGM ? (nM - fm) : WGM;
        u.pm = fm + ((wgid % nig) % gsz); u.pn = (wgid % nig) / gsz; return true;
    }
    __device__ __forceinline__ void a_ready(const Unit&) const {}
    __device__ __forceinline__ void done(const Unit&) const {}
};


typedef float f32x2e __attribute__((ext_vector_type(2)));
typedef unsigned u32x2e __attribute__((ext_vector_type(2)));
__device__ __forceinline__ unsigned cvtpk_e(float lo, float hi) { typedef __bf16 b2 __attribute__((ext_vector_type(2))); f32x2e v = {lo, hi}; b2 b = __builtin_convertvector(v, b2); return __builtin_bit_cast(unsigned, b); }
__device__ __forceinline__ u32x2e pack4e(f32x4 v) { u32x2e r; r.x = cvtpk_e(v[0], v[1]); r.y = cvtpk_e(v[2], v[3]); return r; }

struct EpiProj {
    static constexpr bool PERM = false, AFTER_DRAIN = false;
    unsigned long long* ssq_q; unsigned long long* ssq_kv; const f32x2e* cs;
    bf16_t* CQ; bf16_t* CKV; unsigned char* KM; bf16_t* DQ; unsigned char* DKI; unsigned char* DVI;
    __device__ __forceinline__ void operator()(const f32x4 (&acc)[2][2][4][2], const Unit& u, int wr, int wc, int fr, int fq) const {
        const int pn = u.pn;
        const int row0 = u.pm * BM + wr * 64 + fr;
        if (pn <= 2) {
#pragma unroll
            for (int ai = 0; ai < 2; ++ai)
#pragma unroll
                for (int m = 0; m < 4; ++m) {
                    const int row = row0 + ai * HALF + m * 16; float s = 0.f;
#pragma unroll
                    for (int bj = 0; bj < 2; ++bj) {
                        if (pn == 1 && bj == 1) continue;
#pragma unroll
                        for (int n = 0; n < 2; ++n) {
                            const f32x4 v = acc[ai][bj][m][n]; s += (v[0] * v[0] + v[1] * v[1]) + (v[2] * v[2] + v[3] * v[3]);
                            const int col = bj * HALF + wc * 32 + n * 16 + fq * 4;
                            if (pn == 2) *(u32x2e*)(CKV + (size_t)row * 256 + col) = pack4e(v);
                            else *(u32x2e*)(CQ + (size_t)row * 384 + pn * 256 + col) = pack4e(v);
                        }
                    }
                    s += __shfl_xor(s, 16); s += __shfl_xor(s, 32);
                    if (fq == 0) atomicAdd((pn == 2 ? ssq_kv : ssq_q) + row, (unsigned long long)(s * 4294967296.0f));
                }
            if (pn == 1 && wc == 0) {
#pragma unroll
                for (int ai = 0; ai < 2; ++ai)
#pragma unroll
                    for (int m = 0; m < 4; ++m) {
                        const int row = row0 + ai * HALF + m * 16;
                        const f32x4 x1 = acc[ai][1][m][0], x2 = acc[ai][1][m][1];
                        f32x4 o1, o2;
#pragma unroll
                        for (int i = 0; i < 4; ++i) { const f32x2e c = cs[(size_t)row * 32 + 2 * (4 * fq + i)]; o1[i] = x1[i] * c.x - x2[i] * c.y; o2[i] = x2[i] * c.x + x1[i] * c.y; }
                        const int b = row >> 11, sq = row & 2047, t = sq >> 6, kr = sq & 63;
                        const u32x2e w1 = pack4e(o1), w2 = pack4e(o2);
#pragma unroll
                        for (int h = 0; h < 8; ++h) {
                            unsigned char* base = KM + ((size_t)((b * 8 + h) * 32 + t)) * 12288 + kr * 16 + (fq & 1) * 8;
                            *(u32x2e*)(base + (8 + (fq >> 1)) * 1024) = w1;
                            *(u32x2e*)(base + (10 + (fq >> 1)) * 1024) = w2;
                        }
                    }
            }
        } else if (pn <= 6) {
            const int g = wc & 1; const bool isq = pn <= 4; const int pt = isq ? pn - 3 : pn - 5;
#pragma unroll
            for (int ai = 0; ai < 2; ++ai)
#pragma unroll
                for (int m = 0; m < 4; ++m) {
                    const int row = row0 + ai * HALF + m * 16;
                    const int f1 = 16 * g + 4 * fq;
                    const f32x4 cA = *(const f32x4*)(cs + (size_t)row * 32 + f1), cB = *(const f32x4*)(cs + (size_t)row * 32 + f1 + 2);
                    const int b = row >> 11, sq = row & 2047, t = sq >> 6, kr = sq & 63;
#pragma unroll
                    for (int bj = 0; bj < 2; ++bj) {
                        const int chunk = 4 * pt + 2 * bj + (wc >> 1);
                        const f32x4 x1 = acc[ai][bj][m][0], x2 = acc[ai][bj][m][1];
                        f32x4 o1, o2;
                        o1[0] = x1[0] * cA[0] - x2[0] * cA[1]; o2[0] = x2[0] * cA[0] + x1[0] * cA[1];
                        o1[1] = x1[1] * cA[2] - x2[1] * cA[3]; o2[1] = x2[1] * cA[2] + x1[1] * cA[3];
                        o1[2] = x1[2] * cB[0] - x2[2] * cB[1]; o2[2] = x2[2] * cB[0] + x1[2] * cB[1];
                        o1[3] = x1[3] * cB[2] - x2[3] * cB[3]; o2[3] = x2[3] * cB[2] + x1[3] * cB[3];
                        if (isq) {
                            o1 = o1 * QSCALE_D; o2 = o2 * QSCALE_D;
                            bf16_t* p = DQ + (size_t)row * 512 + chunk * 64 + f1;
                            *(u32x2e*)p = pack4e(o1); *(u32x2e*)(p + 32) = pack4e(o2);
                        } else {
                            unsigned char* base = DKI + ((size_t)((b * 8 + chunk) * 32 + t)) * 8192 + kr * 16 + (fq & 1) * 8 + (2 * g + (fq >> 1)) * 1024;
                            *(u32x2e*)base = pack4e(o1); *(u32x2e*)(base + 4096) = pack4e(o2);
                        }
                    }
                }
        } else {
#pragma unroll
            for (int ai = 0; ai < 2; ++ai)
#pragma unroll
                for (int m = 0; m < 4; ++m) {
                    const int row = row0 + ai * HALF + m * 16;
                    const int b = row >> 11, sq = row & 2047, t = sq >> 6, kr = sq & 63;
#pragma unroll
                    for (int bj = 0; bj < 2; ++bj) {
                        const int h4 = 2 * (pn - 7) + bj;
                        unsigned char* base = DVI + ((size_t)((b * 4 + h4) * 32 + t)) * 16384 + wc * 4096 + kr * 64 + fq * 8;
#pragma unroll
                        for (int n = 0; n < 2; ++n) *(u32x2e*)(base + n * 32) = pack4e(acc[ai][bj][m][n]);
                    }
                }
        }
    }
};

struct EpiMlaQ {
    static constexpr bool PERM = false, AFTER_DRAIN = false;
    const unsigned long long* ssq_q; const f32x2e* cs; bf16_t* QM;
    __device__ __forceinline__ void operator()(const f32x4 (&acc)[2][2][4][2], const Unit& u, int wr, int wc, int fr, int fq) const {
        const int row0 = u.pm * BM + wr * 64 + fr;
        int hh[2], pp[2];
#pragma unroll
        for (int bj = 0; bj < 2; ++bj) { const int G = 8 * u.pn + 4 * bj + wc; hh[bj] = G / 3; pp[bj] = G - 3 * hh[bj]; }
#pragma unroll
        for (int ai = 0; ai < 2; ++ai)
#pragma unroll
            for (int m = 0; m < 4; ++m) {
                const int row = row0 + ai * HALF + m * 16;
                const float rs = __builtin_amdgcn_rsqf((float)ssq_q[row] * (2.3283064365386963e-10f / 384.0f) + EPS) * QSCALE_M;
#pragma unroll
                for (int bj = 0; bj < 2; ++bj) {
                    bf16_t* p = QM + ((unsigned)row * 768u + (unsigned)(hh[bj] * 96 + pp[bj] * 32 + fq * 4));
                    if (pp[bj] < 2) {
#pragma unroll
                        for (int n = 0; n < 2; ++n) *(u32x2e*)(p + n * 16) = pack4e(acc[ai][bj][m][n] * rs);
                    } else {
                        const f32x4 x1 = acc[ai][bj][m][0] * rs, x2 = acc[ai][bj][m][1] * rs; f32x4 o1, o2;
                        const f32x2e* cp = cs + ((unsigned)row * 32u + 8u * (unsigned)fq);
#pragma unroll
                        for (int i = 0; i < 4; ++i) { const f32x2e c = cp[2 * i]; o1[i] = x1[i] * c.x - x2[i] * c.y; o2[i] = x2[i] * c.x + x1[i] * c.y; }
                        *(u32x2e*)p = pack4e(o1); *(u32x2e*)(p + 16) = pack4e(o2);
                    }
                }
                asm volatile("" ::: "memory");
            }
    }
};
struct EpiMlaKV {
    static constexpr bool PERM = false, AFTER_DRAIN = false;
    const unsigned long long* ssq_kv; unsigned char* KM; unsigned char* VM;
    __device__ __forceinline__ void operator()(const f32x4 (&acc)[2][2][4][2], const Unit& u, int wr, int wc, int fr, int fq) const {
        const int row0 = u.pm * BM + wr * 64 + fr;
        const int G0 = 8 * u.pn + wc, h0 = G0 >> 2, part = G0 & 3;
        const bool isk = part < 2;
        unsigned char* const B = isk ? KM : VM;
        const unsigned tile_b = isk ? 12288u : 8192u;
        const unsigned lane_off = isk ? (unsigned)((fq & 1) * 8 + (4 * part + (fq >> 1)) * 1024) : (unsigned)((part - 2) * 4096 + fq * 8);
        const unsigned row_b = isk ? 16u : 64u, n_b = isk ? 2048u : 32u;
#pragma unroll
        for (int ai = 0; ai < 2; ++ai)
#pragma unroll
            for (int m = 0; m < 4; ++m) {
                const int row = row0 + ai * HALF + m * 16;
                const float rs = __builtin_amdgcn_rsqf((float)ssq_kv[row] * (2.3283064365386963e-10f / 256.0f) + EPS);
                const unsigned b = (unsigned)row >> 11, sq = (unsigned)row & 2047u, t = sq >> 6, kr = sq & 63u;
#pragma unroll
                for (int bj = 0; bj < 2; ++bj) {
                    const unsigned off = ((b * 8u + (unsigned)(h0 + bj)) * 32u + t) * tile_b + kr * row_b + lane_off;
#pragma unroll
                    for (int n = 0; n < 2; ++n) *(u32x2e*)(B + off + n * n_b) = pack4e(acc[ai][bj][m][n] * rs);
                }
                asm volatile("" ::: "memory");
            }
    }
};
struct EpiWo {
    static constexpr bool PERM = false, AFTER_DRAIN = false;
    const float* x; bf16_t* HB;
    __device__ __forceinline__ void operator()(const f32x4 (&acc)[2][2][4][2], const Unit& u, int wr, int wc, int fr, int fq) const {
        const int row0 = u.pm * BM + wr * 64 + fr, col0 = u.pn * BM + wc * 32 + 4 * fq;
#pragma unroll
        for (int ai = 0; ai < 2; ++ai)
#pragma unroll
            for (int m = 0; m < 4; ++m) { const unsigned off = (unsigned)(row0 + ai * HALF + m * 16) * 1024u + (unsigned)col0;
#pragma unroll
                for (int bj = 0; bj < 2; ++bj)
#pragma unroll
                    for (int n = 0; n < 2; ++n) *(u32x2e*)(HB + off + bj * HALF + n * 16) = pack4e(*(const f32x4*)(x + off + bj * HALF + n * 16) + acc[ai][bj][m][n]);
                asm volatile("" ::: "memory"); }
    }
};
struct EpiGateUp {
    static constexpr bool PERM = false, AFTER_DRAIN = false;
    const float* GWT; const float* RST; const PG8_LAS int* pbase; bf16_t* HDN;
    __device__ __forceinline__ void operator()(const f32x4 (&acc)[2][2][4][2], const Unit& u, int wr, int wc, int fr, int fq) const {
        const int e = u.pn >> 1, pl = u.pn & 1, j = u.pm - __builtin_amdgcn_readfirstlane(pbase[e]);
        const int r0 = wr * 64 + fr; const unsigned ib = (unsigned)(e * 16384 + 256 * j);
#pragma unroll
        for (int ai = 0; ai < 2; ++ai)
#pragma unroll
            for (int m = 0; m < 4; ++m) {
                const int r = r0 + ai * HALF + m * 16; const float gw = GWT[ib + r], rs = RST[ib + r];
#pragma unroll
                for (int bj = 0; bj < 2; ++bj) {
                    const f32x4 a = acc[ai][bj][m][0] * rs, uu = acc[ai][bj][m][1] * (rs * gw); f32x4 o;
#pragma unroll
                    for (int i = 0; i < 4; ++i) { const float sg = __builtin_amdgcn_rcpf(1.0f + __builtin_amdgcn_exp2f(-a[i] * LOG2E)); o[i] = a[i] * sg * uu[i]; }
                    *(u32x2e*)(HDN + (unsigned)(u.pm * BM + r) * 256u + (unsigned)(16 * (8 * pl + 4 * bj + wc) + 4 * fq)) = pack4e(o);
                }
                asm volatile("" ::: "memory");
            }
    }
};
struct EpiDown {
    static constexpr bool PERM = false, AFTER_DRAIN = false;
    bf16_t* Y;
    __device__ __forceinline__ void operator()(const f32x4 (&acc)[2][2][4][2], const Unit& u, int wr, int wc, int fr, int fq) const {
        const int row0 = u.pm * BM + wr * 64 + fr, col0 = (u.pn & 3) * BM + wc * 32 + 4 * fq;
#pragma unroll
        for (int ai = 0; ai < 2; ++ai)
#pragma unroll
            for (int m = 0; m < 4; ++m) { const size_t off = (size_t)(row0 + ai * HALF + m * 16) * 1024 + col0;
#pragma unroll
                for (int bj = 0; bj < 2; ++bj)
#pragma unroll
                    for (int n = 0; n < 2; ++n) *(u32x2e*)(Y + off + bj * HALF + n * 16) = pack4e(acc[ai][bj][m][n]); }
    }
};
struct MoeOrder {
    const PG8_LAS int* pexp; const PG8_LAS int* tokl; int npan, ntn, G, vc;
    __device__ __forceinline__ void init(const PG8_LAS int* pexp_, const PG8_LAS int* tokl_, int ntn_, int G_, int bx) { pexp = pexp_; tokl = tokl_; ntn = ntn_; G = G_; vc = (G_ % 8 == 0) ? (bx % 8) * (G_ / 8) + bx / 8 : bx;
        npan = __builtin_amdgcn_readfirstlane(pexp_[MAXPANEL]); if (npan > MAXPANEL) npan = MAXPANEL; if (npan < 0) npan = 0; }
    __device__ __forceinline__ bool next(int i, Unit& u) const {
        const int L = i * G + vc; if (L >= npan * ntn) return false;
        const int p = L / ntn, pl = L - p * ntn; const int e = __builtin_amdgcn_readfirstlane(pexp[p]) & 31;
        u.pm = p; u.pn = e * ntn + pl; return true;
    }
    __device__ __forceinline__ const PG8_LAS int* toks(int ui) const { return tokl + 256 * ui; }
    __device__ __forceinline__ void a_ready(const Unit&) const {}
    __device__ __forceinline__ void done(const Unit&) const {}
};
template <class Epi, class Sched, bool ALIGN_EPI = false, bool SP2 = false, bool GATHER = false>
__device__ __forceinline__ void gemm_phase(PG8_LAS unsigned char* lds, const Gemm g, const Sched& S, const Epi& E) {
    const int tid = threadIdx.x, wid = __builtin_amdgcn_readfirstlane(tid >> 6), lane = tid & 63, wr = wid >> 2, wc = wid & 3, fr = lane & 15, fq = lane >> 4;
    int K_ = g.K; asm volatile("" : "+s"(K_));
    const int K = K_, nt = K / BK;
    static_assert(!GATHER || SP2, "row gather is implemented on the SP2 loop only");
    unsigned voffA[2], voffB[2]; int gR0 = 0, gR1 = 0; unsigned gC0 = 0, gC1 = 0;
#pragma unroll
    for (int i = 0; i < 2; ++i) { int R, C; stage_rc(tid * 16 + i * 8192, R, C); const int Rb = Epi::PERM ? ((R & ~31) + perm32(R & 31)) : R;
        voffA[i] = (unsigned)(R * K + C) * 2u; voffB[i] = (unsigned)(Rb * K + C) * 2u; if (i == 0) { gR0 = R; gC0 = (unsigned)C * 2u; } else { gR1 = R; gC1 = (unsigned)C * 2u; } }
    const size_t kstep = (size_t)(BK * 2);
    const size_t hstep = (size_t)HALF * K * 2;
    const size_t tstep = 2 * hstep;
    const unsigned ldsw = (unsigned)wid * 1024u;
    const int aoff = lds_byte(wr * 64 + fr, fq * 8), boff = lds_byte(wc * 32 + fr, fq * 8);
#define PG8_SA(b, h) (((b) * 2 + (h)) * HTB)
#define PG8_SB(b, h) ((4 + (b) * 2 + (h)) * HTB)
#define PG8_STAGE(bufoff, gbase, voff) do { _Pragma("unroll") for (int _i = 0; _i < 2; ++_i) \
        __builtin_amdgcn_global_load_lds((const unsigned*)((const char*)(gbase) + (voff)[_i]), (PG8_LAS unsigned*)(lds + (bufoff) + ldsw + _i * 8192), 16, 0, 0); } while (0)
#define PG8_STAGE2(bufoff, gbase, v0, v1) do { \
        __builtin_amdgcn_global_load_lds((const unsigned*)((const char*)(gbase) + (v0)), (PG8_LAS unsigned*)(lds + (bufoff) + ldsw), 16, 0, 0); \
        __builtin_amdgcn_global_load_lds((const unsigned*)((const char*)(gbase) + (v1)), (PG8_LAS unsigned*)(lds + (bufoff) + ldsw + 8192), 16, 0, 0); } while (0)
#define PG8_STAGE_A(bufoff, gbase, h, nx) do { if constexpr (GATHER) { PG8_STAGE2(bufoff, gbase, (nx) ? gN##h##0 : gA##h##0, (nx) ? gN##h##1 : gA##h##1); } else { PG8_STAGE(bufoff, (gbase) + (h) * hstep, voffA); } } while (0)
#define PG8_GLOAD(P, tl) do { const PG8_LAS int* tl_ = (tl); const unsigned kb_ = (unsigned)K * 2u; \
        P##00 = (unsigned)tl_[gR0] * kb_ + gC0; P##01 = (unsigned)tl_[gR1] * kb_ + gC1; P##10 = (unsigned)tl_[HALF + gR0] * kb_ + gC0; P##11 = (unsigned)tl_[HALF + gR1] * kb_ + gC1; } while (0)
#define PG8_LDA(dst, b, h) do { _Pragma("unroll") for (int m = 0; m < 4; ++m) _Pragma("unroll") for (int k = 0; k < 2; ++k) dst[m][k] = *(const PG8_LAS bf16x8*)(lds + PG8_SA(b, h) + aoff + m * 2048 + k * 1024); } while (0)
#define PG8_LDB(dst, b, h) do { _Pragma("unroll") for (int n = 0; n < 2; ++n) _Pragma("unroll") for (int k = 0; k < 2; ++k) dst[n][k] = *(const PG8_LAS bf16x8*)(lds + PG8_SB(b, h) + boff + n * 2048 + k * 1024); } while (0)
#define PG8_MMA(ai, bj, At, Bt) do { __builtin_amdgcn_s_setprio(1); _Pragma("unroll") for (int m = 0; m < 4; ++m) _Pragma("unroll") for (int n = 0; n < 2; ++n) _Pragma("unroll") for (int k = 0; k < 2; ++k) \
        acc[ai][bj][m][n] = __builtin_amdgcn_mfma_f32_16x16x32_bf16(Bt[n][k], At[m][k], acc[ai][bj][m][n], 0, 0, 0); __builtin_amdgcn_s_setprio(0); } while (0)
#define PG8_WAIT_V(n) asm volatile("s_waitcnt vmcnt(" #n ")" ::: "memory")
#define PG8_WAIT_L(n) asm volatile("s_waitcnt lgkmcnt(" #n ")" ::: "memory")
#define PG8_BAR __builtin_amdgcn_s_barrier()
#define PG8_SCHED __builtin_amdgcn_sched_barrier(0)
    Unit cur, nxt; int ui = 0;
    if (!S.next(0, cur)) return;
    f32x4 acc[2][2][4][2];
#pragma unroll
    for (int a = 0; a < 2; ++a)
#pragma unroll
        for (int b = 0; b < 2; ++b)
#pragma unroll
            for (int m = 0; m < 4; ++m)
#pragma unroll
                for (int n = 0; n < 2; ++n) acc[a][b][m][n] = (f32x4){0.f, 0.f, 0.f, 0.f};
    bf16x8 At[4][2], B0[2][2], B1[2][2];
    const char* cA = (const char*)g.A + (GATHER ? (size_t)0 : (size_t)cur.pm * tstep); const char* cB = (const char*)g.Bt + (size_t)cur.pn * tstep;
    unsigned gA00 = 0, gA01 = 0, gA10 = 0, gA11 = 0, gN00 = 0, gN01 = 0, gN10 = 0, gN11 = 0;
    if constexpr (GATHER) { PG8_GLOAD(gA, S.toks(0)); }
    S.a_ready(cur);
    if constexpr (SP2) {
        PG8_STAGE(PG8_SB(0, 0), cB, voffB); PG8_STAGE(PG8_SB(0, 1), cB + hstep, voffB); PG8_STAGE_A(PG8_SA(0, 0), cA, 0, false); PG8_STAGE_A(PG8_SA(0, 1), cA, 1, false);
        if (wr == 1) PG8_BAR;
        PG8_WAIT_V(2); PG8_BAR;
        PG8_STAGE(PG8_SB(1, 0), cB + kstep, voffB); PG8_STAGE_A(PG8_SA(1, 0), cA + kstep, 0, false); PG8_STAGE(PG8_SB(1, 1), cB + hstep + kstep, voffB);
        PG8_WAIT_V(6); PG8_BAR;
    } else {
        PG8_STAGE(PG8_SB(0, 0), cB, voffB); PG8_STAGE(PG8_SA(0, 0), cA, voffA); PG8_STAGE(PG8_SB(0, 1), cB + hstep, voffB); PG8_STAGE(PG8_SA(0, 1), cA + hstep, voffA);
        if (wr == 1) PG8_BAR;
        PG8_WAIT_V(4); PG8_BAR;
        PG8_STAGE(PG8_SB(1, 0), cB + kstep, voffB); PG8_STAGE(PG8_SA(1, 0), cA + kstep, voffA); PG8_STAGE(PG8_SB(1, 1), cB + hstep + kstep, voffB);
        PG8_WAIT_V(6); PG8_BAR;
    }
    for (;;) {
        const bool has_next = S.next(ui + 1, nxt);
        if constexpr (GATHER) { if (has_next) { PG8_GLOAD(gN, S.toks(ui + 1)); } else { gN00 = gA00; gN01 = gA01; gN10 = gA10; gN11 = gA11; } }
        const char* nA = (has_next && !GATHER) ? (const char*)g.A + (size_t)nxt.pm * tstep : cA; const char* nB = has_next ? (const char*)g.Bt + (size_t)nxt.pn * tstep : cB;
        for (int t = 0; t < nt; t += 2) {
            const bool last = (t == nt - 2);
            const char* a1 = cA + (size_t)(t + 1) * kstep;
            const char* a2 = last ? nA : cA + (size_t)(t + 2) * kstep; const char* b2 = last ? nB : cB + (size_t)(t + 2) * kstep;
            const char* a3 = a2 + kstep; const char* b3 = b2 + kstep;
            if (last && has_next) S.a_ready(nxt);
            if constexpr (SP2) {
            PG8_LDB(B0, 0, 0); PG8_LDB(B1, 0, 1); PG8_SCHED; PG8_LDA(At, 0, 0); PG8_STAGE_A(PG8_SA(1, 1), a1, 1, false);
            PG8_WAIT_V(8); PG8_WAIT_L(0); PG8_BAR; PG8_MMA(0, 0, At, B0); PG8_MMA(0, 1, At, B1); PG8_BAR; PG8_SCHED;
            PG8_LDA(At, 0, 1); PG8_STAGE(PG8_SB(0, 0), b2, voffB); PG8_STAGE(PG8_SB(0, 1), b2 + hstep, voffB); PG8_STAGE_A(PG8_SA(0, 0), a2, 0, last);
            PG8_WAIT_V(8); PG8_WAIT_L(0); PG8_BAR; PG8_MMA(1, 0, At, B0); PG8_MMA(1, 1, At, B1); PG8_BAR; PG8_SCHED;
            PG8_LDB(B0, 1, 0); PG8_LDB(B1, 1, 1); PG8_SCHED; PG8_LDA(At, 1, 0); PG8_STAGE_A(PG8_SA(0, 1), a2, 1, last);
            PG8_WAIT_V(8); PG8_WAIT_L(0); PG8_BAR; PG8_MMA(0, 0, At, B0); PG8_MMA(0, 1, At, B1); PG8_BAR; PG8_SCHED;
            PG8_LDA(At, 1, 1); PG8_STAGE(PG8_SB(1, 0), b3, voffB); PG8_STAGE(PG8_SB(1, 1), b3 + hstep, voffB); PG8_STAGE_A(PG8_SA(1, 0), a3, 0, last);
            PG8_WAIT_V(8); PG8_WAIT_L(0); PG8_BAR; PG8_MMA(1, 0, At, B0); PG8_MMA(1, 1, At, B1); PG8_BAR; PG8_SCHED;
            } else {
            PG8_LDB(B0, 0, 0); PG8_SCHED; PG8_LDA(At, 0, 0); PG8_STAGE(PG8_SA(1, 1), a1 + hstep, voffA);
            PG8_WAIT_L(8); PG8_BAR; PG8_WAIT_L(0); PG8_MMA(0, 0, At, B0); PG8_BAR; PG8_SCHED;
            PG8_LDB(B1, 0, 1); PG8_STAGE(PG8_SB(0, 0), b2, voffB);
            PG8_BAR; PG8_WAIT_L(0); PG8_MMA(0, 1, At, B1); PG8_BAR;
            PG8_LDA(At, 0, 1); PG8_STAGE(PG8_SA(0, 0), a2, voffA);
            PG8_BAR; PG8_WAIT_L(0); PG8_MMA(1, 0, At, B0); PG8_BAR; PG8_SCHED;
            PG8_STAGE(PG8_SB(0, 1), b2 + hstep, voffB);
            PG8_WAIT_V(6); PG8_BAR; PG8_MMA(1, 1, At, B1); PG8_BAR;
            PG8_LDB(B0, 1, 0); PG8_SCHED; PG8_LDA(At, 1, 0); PG8_STAGE(PG8_SA(0, 1), a2 + hstep, voffA);
            PG8_WAIT_L(8); PG8_BAR; PG8_WAIT_L(0); PG8_MMA(0, 0, At, B0); PG8_BAR; PG8_SCHED;
            PG8_LDB(B1, 1, 1); PG8_STAGE(PG8_SB(1, 0), b3, voffB);
            PG8_BAR; PG8_WAIT_L(0); PG8_MMA(0, 1, At, B1); PG8_BAR;
            PG8_LDA(At, 1, 1); PG8_STAGE(PG8_SA(1, 0), a3, voffA);
            PG8_BAR; PG8_WAIT_L(0); PG8_MMA(1, 0, At, B0); PG8_BAR; PG8_SCHED;
            PG8_STAGE(PG8_SB(1, 1), b3 + hstep, voffB);
            PG8_WAIT_V(6); PG8_BAR; PG8_MMA(1, 1, At, B1); PG8_BAR;
            }
        }
        if constexpr (ALIGN_EPI) { if (wr == 0) PG8_BAR; }
        if constexpr (!Epi::AFTER_DRAIN) { E(acc, cur, wr, wc, fr, fq); S.done(cur); }
        if (!has_next) break;
#pragma unroll
        for (int a = 0; a < 2; ++a)
#pragma unroll
            for (int b = 0; b < 2; ++b)
#pragma unroll
                for (int m = 0; m < 4; ++m)
#pragma unroll
                    for (int n = 0; n < 2; ++n) acc[a][b][m][n] = (f32x4){0.f, 0.f, 0.f, 0.f};
        cur = nxt; cA = nA; cB = nB; ++ui; if constexpr (GATHER) { gA00 = gN00; gA01 = gN01; gA10 = gN10; gA11 = gN11; }
        if constexpr (ALIGN_EPI) { if (wr == 1) PG8_BAR; }
    }
    PG8_WAIT_V(0);
    if constexpr (!ALIGN_EPI) { if (wr == 0) PG8_BAR; }
    PG8_BAR;
    if constexpr (Epi::AFTER_DRAIN) { E.fused(acc, cur, wr, wc, fr, fq, lds, wid, lane); S.done(cur); }
#undef PG8_SA
#undef PG8_SB
#undef PG8_STAGE
#undef PG8_STAGE2
#undef PG8_STAGE_A
#undef PG8_GLOAD
#undef PG8_LDA
#undef PG8_LDB
#undef PG8_MMA
#undef PG8_WAIT_V
#undef PG8_WAIT_L
#undef PG8_BAR
#undef PG8_SCHED
}
}

namespace att {
typedef LAS const char* lds_cptr;
typedef short v4i16_t __attribute__((ext_vector_type(4)));
constexpr int NSLOT = 4, K_SLOT = 12288, V_SLOT = 16384, LDS_K = 0, LDS_V = NSLOT * K_SLOT, LDS_JUNK = LDS_V + NSLOT * V_SLOT, LDS_WS = LDS_JUNK + 4096, LDS_END = LDS_WS + 2048, LDS_ST = 0;
static_assert(LDS_END <= RING_BYTES && 8 * 8192 <= LDS_JUNK, "attention LDS");
constexpr float THR = 8.f;
__device__ __forceinline__ constexpr int cr(int r) { return (r & 3) + 8 * (r >> 2); }
__device__ __forceinline__ s16x4 vtr(lds_cptr p) { return __builtin_bit_cast(s16x4, __builtin_amdgcn_ds_read_tr16_b64_v4i16((LAS v4i16_t*)p)); }
#define ATT_MFMA(a, b, c) __builtin_amdgcn_mfma_f32_32x32x16_bf16(a, b, c, 0, 0, 0)
#define ATT_BAR() do { asm volatile("s_waitcnt lgkmcnt(0)" ::: "memory"); __builtin_amdgcn_s_barrier(); asm volatile("" ::: "memory"); } while (0)
__device__ __forceinline__ int rowblock(int wid) { return wid < 4 ? wid : 11 - wid; }

__device__ __forceinline__ void glds16(const void* g, unsigned lds_base) {
    unsigned sv; asm volatile("s_mov_b32 %0, m0\n\ts_mov_b32 m0, %2\n\ts_nop 0\n\tglobal_load_lds_dwordx4 %1, off\n\ts_mov_b32 m0, %0" : "=&s"(sv) : "v"(g), "s"(lds_base) : "memory"); }
template <int KCH, int VCH>
__device__ __forceinline__ void issue_tile(const unsigned char* ksrc, const unsigned char* vsrc, unsigned lds0, int slot, int wid) {
    const unsigned kd = (unsigned)__builtin_amdgcn_readfirstlane((int)(lds0 + LDS_K + slot * K_SLOT + wid * 1024)), vd = (unsigned)__builtin_amdgcn_readfirstlane((int)(lds0 + LDS_V + slot * V_SLOT + wid * 1024));
    glds16(ksrc + wid * 1024, kd);
    glds16(vsrc + wid * 1024, vd);
    if (VCH == 16) glds16(vsrc + (wid + 8) * 1024, vd + 8192);
    else if (wid < 4) glds16(ksrc + (wid + 8) * 1024, kd + 8192);
    else glds16(ksrc + wid * 1024, (unsigned)__builtin_amdgcn_readfirstlane((int)(lds0 + LDS_JUNK + (wid - 4) * 1024)));
    static_assert((KCH == 12 && VCH == 8) || (KCH == 8 && VCH == 16), "piece dealing");
}

#define ATT_SB() __builtin_amdgcn_sched_barrier(0)
__device__ __forceinline__ void vread4(bf16x8 (&vf)[4], lds_cptr vp) {
#pragma unroll
    for (int ksl = 0; ksl < 4; ++ksl) { const s16x4 lo = vtr(vp + ksl * 1024), hh = vtr(vp + ksl * 1024 + 512); vf[ksl] = (bf16x8){lo[0], lo[1], lo[2], lo[3], hh[0], hh[1], hh[2], hh[3]}; }
}
template <int NDB>
__device__ __forceinline__ void pv_tile(f32x16 (&o)[NDB], f32x16& l_acc, const bf16x8 (&pa)[4], lds_cptr vp) {
    const bf16x8 ones = (bf16x8){0x3F80, 0x3F80, 0x3F80, 0x3F80, 0x3F80, 0x3F80, 0x3F80, 0x3F80};
    bf16x8 va[4], vb[4];
    ATT_SB();
    vread4(va, vp);
    ATT_SB();
#pragma unroll
    for (int ksl = 0; ksl < 4; ++ksl) l_acc = ATT_MFMA(pa[ksl], ones, l_acc);
#pragma unroll
    for (int d = 0; d < NDB; d += 2) {
        vread4(vb, vp + (d + 1) * 4096);
#pragma unroll
        for (int ksl = 0; ksl < 4; ++ksl) o[d] = ATT_MFMA(pa[ksl], va[ksl], o[d]);
        ATT_SB();
        if (d + 2 < NDB) vread4(va, vp + (d + 2) * 4096);
#pragma unroll
        for (int ksl = 0; ksl < 4; ++ksl) o[d + 1] = ATT_MFMA(pa[ksl], vb[ksl], o[d + 1]);
        ATT_SB();
    }
}

template <int DK, int DV, int VAR>
__device__ __forceinline__ void attn_pass(const bf16* Qu, int qpitch, const unsigned char* kimg, const unsigned char* vimg, int qb, LAS unsigned char* lds, int wid, int lane, f32x16 (&o)[DV / 32]) {
    constexpr int KCH = DK / 8, VCH = DV / 8, KTB = KCH * 1024, VTB = VCH * 1024, ND0 = DK / 16, NDB = DV / 32;
    const int r32 = lane & 31, hi = lane >> 5, grp = wid >> 2, rb = rowblock(wid);
    const int NT = 4 * qb + 4, tlast = 4 * qb + (rb >> 1), limh = 32 * (rb & 1) + r32 - 4 * hi;
    const bf16* Qw = Qu + (size_t)(rb * 32) * qpitch;
    bf16x8 qr[ND0];
#pragma unroll
    for (int d0 = 0; d0 < ND0; ++d0) qr[d0] = *(const bf16x8*)(Qw + (size_t)r32 * qpitch + d0 * 16 + hi * 8);
#pragma unroll
    for (int d = 0; d < NDB; ++d) o[d] = f32x16{};
    f32x16 l_acc = f32x16{}, negm = f32x16{}; float mref = 0.f;
    LAS float* wsfh = (LAS float*)(lds + LDS_WS) + wid * 64 + 4 * hi;
    const unsigned char* ks = kimg + lane * 16; const unsigned char* vs = vimg + lane * 16;
    const lds_cptr kb0 = (lds_cptr)lds + LDS_K + hi * 1024 + r32 * 16;
    const lds_cptr vp0 = (lds_cptr)lds + LDS_V + ((lane >> 4) & 1) * 32 + (lane & 3) * 8 + (4 * hi + ((lane & 15) >> 2)) * 64;
    bf16x8 pa[4]; pa[0] = bf16x8{}; pa[1] = bf16x8{}; pa[2] = bf16x8{}; pa[3] = bf16x8{};
    __syncthreads();
    const unsigned lds0 = (unsigned)(uintptr_t)lds;
    issue_tile<KCH, VCH>(ks, vs, lds0, 0, wid);
    issue_tile<KCH, VCH>(ks + KTB, vs + VTB, lds0, 1, wid);
#pragma unroll
    for (int d0 = 0; d0 < ND0; ++d0) asm volatile("" : "+v"(qr[d0]));
    asm volatile("s_waitcnt vmcnt(3)" ::: "memory"); __builtin_amdgcn_s_barrier(); asm volatile("" ::: "memory");
    for (int s = 0; s <= NT; ++s) {
        const bool issued = s + 2 < NT;
        if (issued) issue_tile<KCH, VCH>(ks + (size_t)(s + 2) * KTB, vs + (size_t)(s + 2) * VTB, lds0, (s + 2) & 3, wid);
        if (grp == 1 && s >= 1 && s - 1 <= tlast) { if constexpr (VAR & 2) { asm volatile("" : "+v"(o[0]) : "v"(pa[0]), "v"(pa[1]), "v"(pa[2]), "v"(pa[3])); } else pv_tile<NDB>(o, l_acc, pa, vp0 + ((s - 1) & 3) * V_SLOT); }
        if (s < NT && s <= tlast) {
            const lds_cptr kb = kb0 + (s & 3) * K_SLOT;
            f32x16 p0, p1; bf16x8 kf[2 * ND0];
            ATT_SB();
#pragma unroll
            for (int d0 = 0; d0 < ND0; ++d0) { if constexpr (VAR & 32) { kf[2 * d0] = qr[d0]; kf[2 * d0 + 1] = qr[d0]; } else { kf[2 * d0] = *(const LAS bf16x8*)(kb + d0 * 2048); kf[2 * d0 + 1] = *(const LAS bf16x8*)(kb + d0 * 2048 + 512); } }
            ATT_SB();
#pragma unroll
            for (int d0 = 0; d0 < ND0; ++d0) {
                if constexpr (VAR & 4) { if (d0 == 0) { p0 = negm; p1 = negm; } asm volatile("" : "+v"(p0), "+v"(p1) : "v"(kf[2 * d0]), "v"(kf[2 * d0 + 1])); }
                else if (d0 == 0) { p0 = ATT_MFMA(kf[0], qr[0], negm); p1 = ATT_MFMA(kf[1], qr[0], negm); }
                else { p0 = ATT_MFMA(kf[2 * d0], qr[d0], p0); p1 = ATT_MFMA(kf[2 * d0 + 1], qr[d0], p1); }
            }
            ATT_SB();
            if (s == tlast) {
#pragma unroll
                for (int r = 0; r < 16; ++r) { if (cr(r) > limh) p0[r] = -INFINITY; if (cr(r) + 32 > limh) p1[r] = -INFINITY; }
            }
            float rm = __builtin_fmaxf(p0[0], p1[0]);
#pragma unroll
            for (int r = 1; r < 16; ++r) rm = __builtin_fmaxf(__builtin_fmaxf(rm, p0[r]), p1[r]);
            { auto rr = __builtin_amdgcn_permlane32_swap(__float_as_uint(rm), __float_as_uint(rm), false, false); rm = __builtin_fmaxf(__uint_as_float(rr[0]), __uint_as_float(rr[1])); }
            if (s == 0 || __any(rm > THR)) {
                const float dl = s == 0 ? rm : __builtin_fmaxf(rm, 0.f), f = s == 0 ? 1.f : __builtin_amdgcn_exp2f(-dl); mref += dl;
#pragma unroll
                for (int r = 0; r < 16; ++r) { p0[r] -= dl; p1[r] -= dl; negm[r] = -mref; }
                if (hi == 0) wsfh[r32] = f;
                LDS_WAIT();
#pragma unroll
                for (int r = 0; r < 16; ++r) { const float fr_ = wsfh[cr(r)]; l_acc[r] *= fr_;
#pragma unroll
                    for (int d = 0; d < NDB; ++d) o[d][r] *= fr_; }
            }
#pragma unroll
            for (int r = 0; r < 16; ++r) { if constexpr (VAR & 1) { p0[r] *= 0.001f; p1[r] *= 0.001f; } else { p0[r] = __builtin_amdgcn_exp2f(p0[r]); p1[r] = __builtin_amdgcn_exp2f(p1[r]); } }
            { v4u w;
              w.x = cvtpk(p0[0], p0[1]); w.y = cvtpk(p0[2], p0[3]); w.z = cvtpk(p0[4], p0[5]); w.w = cvtpk(p0[6], p0[7]); pa[0] = __builtin_bit_cast(bf16x8, w);
              w.x = cvtpk(p0[8], p0[9]); w.y = cvtpk(p0[10], p0[11]); w.z = cvtpk(p0[12], p0[13]); w.w = cvtpk(p0[14], p0[15]); pa[1] = __builtin_bit_cast(bf16x8, w);
              w.x = cvtpk(p1[0], p1[1]); w.y = cvtpk(p1[2], p1[3]); w.z = cvtpk(p1[4], p1[5]); w.w = cvtpk(p1[6], p1[7]); pa[2] = __builtin_bit_cast(bf16x8, w);
              w.x = cvtpk(p1[8], p1[9]); w.y = cvtpk(p1[10], p1[11]); w.z = cvtpk(p1[12], p1[13]); w.w = cvtpk(p1[14], p1[15]); pa[3] = __builtin_bit_cast(bf16x8, w); }
            if (grp == 0) { if constexpr (VAR & 2) { asm volatile("" : "+v"(o[0]) : "v"(pa[0]), "v"(pa[1]), "v"(pa[2]), "v"(pa[3])); } else pv_tile<NDB>(o, l_acc, pa, vp0 + (s & 3) * V_SLOT); }
        }
        if (issued) asm volatile("s_waitcnt vmcnt(3)" ::: "memory"); else asm volatile("s_waitcnt vmcnt(0)" ::: "memory");
        if constexpr (VAR & 16) { asm volatile("s_waitcnt lgkmcnt(0)" ::: "memory"); } else { ATT_BAR(); }
    }
#pragma unroll
    for (int r = 0; r < 16; ++r) { const float rl = __builtin_amdgcn_rcpf(l_acc[r]);
#pragma unroll
        for (int d = 0; d < NDB; ++d) o[d][r] *= rl; }
}

struct AttnArgs { const bf16* QM; const unsigned char* KM; const unsigned char* VM; const bf16* DQ; const unsigned char* DKI; const unsigned char* DVI; bf16* ATT; const float* subln_g; float lam; v4u* stash; };

template <int VAR> __device__ __forceinline__ void mla_unit(const AttnArgs& A, int b, int h, int qb, LAS unsigned char* lds, int wid, int lane_in) {
    int lane = lane_in; asm volatile("" : "+v"(lane));
    const int r32 = lane & 31, hi = lane >> 5; const size_t mu = (size_t)b * SEQ + qb * 256, m0 = mu + rowblock(wid) * 32;
    f32x16 o[2];
    attn_pass<96, 64, VAR>(A.QM + mu * 768 + h * 96, 768, A.KM + (size_t)((b * 8 + h) * 32) * 12288, A.VM + (size_t)((b * 8 + h) * 32) * 8192, qb, lds, wid, lane, o);
    LAS bf16* stg = (LAS bf16*)(lds + LDS_ST + wid * 8192); LAS bf16* sb = stg + (4 * hi) * 64 + r32; asm volatile("" : "+v"(sb));
#pragma unroll
    for (int r = 0; r < 16; ++r)
#pragma unroll
        for (int d = 0; d < 2; ++d) sb[cr(r) * 64 + d * 32] = (bf16)f2bf(o[d][r]);
    LDS_WAIT();
#pragma unroll
    for (int i = 0; i < 4; ++i) { const int row = i * 8 + (lane >> 3), ch = lane & 7; const v4u v = *(const LAS v4u*)(stg + row * 64 + ch * 8); if constexpr (VAR & 8) { asm volatile("" :: "v"(v)); } else *(v4u*)(A.ATT + (m0 + row) * 1024 + h * 64 + ch * 8) = v; }
    LDS_WAIT();
}
template <int VAR> __device__ __forceinline__ void diff_unit(const AttnArgs& A, int b, int h4, int qb, LAS unsigned char* lds, int wid, int lane_in) {
    int lane = lane_in; asm volatile("" : "+v"(lane));
    const int r32 = lane & 31, hi = lane >> 5; const size_t mu = (size_t)b * SEQ + qb * 256, m0 = mu + rowblock(wid) * 32;
    LAS bf16* stg = (LAS bf16*)(lds + LDS_ST + wid * 8192); LAS bf16* sb = stg + (4 * hi) * 128 + r32; asm volatile("" : "+v"(sb));
    const unsigned char* vimg = A.DVI + (size_t)((b * 4 + h4) * 32) * 16384;
    v4u* st = A.stash + (size_t)wid * 512 + lane;
    f32x16 o[4];
#pragma unroll 1
    for (int half = 0; half < 2; ++half) {
        attn_pass<64, 128, VAR>(A.DQ + mu * 512 + (h4 * 2 + half) * 64, 512, A.DKI + (size_t)((b * 8 + h4 * 2 + half) * 32) * 8192, vimg, qb, lds, wid, lane, o);
        if (half == 0) {
#pragma unroll
            for (int d = 0; d < 4; ++d)
#pragma unroll
                for (int i = 0; i < 2; ++i) { v4u w;
#pragma unroll
                    for (int j = 0; j < 4; ++j) w[j] = cvtpk(o[d][8 * i + 2 * j], o[d][8 * i + 2 * j + 1]);
                    st[64 * (2 * d + i)] = w; }
        }
    }
    {
        const float lam = A.lam;
#pragma unroll
        for (int d = 0; d < 4; ++d)
#pragma unroll
            for (int i = 0; i < 2; ++i) { const v4u w = st[64 * (2 * d + i)];
#pragma unroll
                for (int j = 0; j < 4; ++j) { const int r = 8 * i + 2 * j; const float a0 = bf2f(w[j] & 0xffffu), a1 = bf2f(w[j] >> 16);
                    sb[cr(r) * 128 + d * 32] = (bf16)f2bf(a0 - lam * o[d][r]); sb[cr(r + 1) * 128 + d * 32] = (bf16)f2bf(a1 - lam * o[d][r + 1]); } }
    }
    LDS_WAIT();
    {
        const int row = lane >> 1, hf = lane & 1;
        v4u v[8]; float ss = 0.f;
#pragma unroll
        for (int i = 0; i < 8; ++i) { v[i] = *(const LAS v4u*)(stg + row * 128 + hf * 64 + i * 8);
#pragma unroll
            for (int j = 0; j < 4; ++j) { const float x0 = bf2f(v[i][j] & 0xffffu), x1 = bf2f(v[i][j] >> 16); ss += x0 * x0 + x1 * x1; } }
        ss += __shfl_xor(ss, 1);
        const float rs = __builtin_amdgcn_rsqf(ss * (1.0f / 128.0f) + EPS) * (1.0f - LAM_INIT);
        bf16* op = A.ATT + (m0 + row) * 1024 + 512 + h4 * 128 + hf * 64;
        const float* gp = A.subln_g + hf * 64; asm volatile("" : "+v"(gp));
#pragma unroll
        for (int i = 0; i < 8; ++i) { v4u w;
#pragma unroll
            for (int j = 0; j < 4; ++j) { const float x0 = bf2f(v[i][j] & 0xffffu) * rs * gp[i * 8 + 2 * j], x1 = bf2f(v[i][j] >> 16) * rs * gp[i * 8 + 2 * j + 1]; w[j] = cvtpk(x0, x1); }
            if constexpr (VAR & 8) { asm volatile("" :: "v"(w)); } else *(v4u*)(op + i * 8) = w; }
    }
    LDS_WAIT();
}

__device__ __forceinline__ unsigned mla_list(int d, int& cnt) {
    switch (d) {
        case 0: cnt = 5; return 0x82B34u;
        case 1: cnt = 3; return 0x9DEu;
        case 2: cnt = 2; return 0x56u;
        case 3: cnt = 2; return 0x1Fu;
        case 4: cnt = 1; return 0x7u;
        case 5: cnt = 1; return 0xCu;
        case 6: cnt = 1; return 0xAu;
        default: cnt = 1; return 0x0u;
    }
}
template <int VAR> __device__ __forceinline__ void attn_phase(const AttnArgs& A, LAS unsigned char* lds, int vcu, int G, int wid, int lane) {
    for (int v = vcu; v < 256; v += G) {
        const int g = v >> 3, d = v & 7, b = g >> 2;
        diff_unit<VAR>(A, b, g & 3, d, lds, wid, lane);
        int cnt; unsigned lst = mla_list(d, cnt);
        for (int i = 0; i < cnt; ++i) { const int e = (lst >> (4 * i)) & 15; mla_unit<VAR>(A, b, 2 * (g & 3) + (e >> 3), e & 7, lds, wid, lane); }
    }
}
#undef ATT_MFMA
}

constexpr int NWAVES = 8;
constexpr int N_LAUNCHES = MK_N_LAUNCHES;
constexpr int PER_PHASE = 10;
constexpr int PEXP_LDS_OFF = LDSCTL_OFF + 1024;

struct In {
    const float* x; const int* positions; const float* attn_norm_g; const float* w_in; const float* q_norm_g; const float* w_uq; const float* kv_norm_g; const float* w_ukv;
    const float* lq1; const float* lk1; const float* lq2; const float* lk2; const float* subln_g; const float* w_o; const float* ffn_norm_g; const float* w_rg; const float* b_rg;
    const float* w_re; const float* b_re; const float* w_gate; const float* w_up; const float* w_down; const float* final_g;
};
struct Args { In in; float* out; unsigned char* ws; int ph_lo, ph_hi, li, pad; };


__device__ const float INVF[32] = {1.f, 0.749894261f, 0.562341332f, 0.421696514f, 0.316227764f, 0.237137377f, 0.177827939f, 0.133352131f, 0.100000001f, 0.0749894157f, 0.0562341325f, 0.0421696529f, 0.0316227749f, 0.0237137377f,
    0.0177827943f, 0.0133352149f, 0.00999999978f, 0.00749894185f, 0.00562341325f, 0.00421696482f, 0.00316227763f, 0.00237137359f, 0.00177827943f, 0.00133352145f, 0.00100000005f, 0.000749894243f, 0.000562341302f, 0.000421696517f,
    0.000316227757f, 0.00023713737f, 0.00017782794f, 0.00013335215f};
__device__ __forceinline__ void sincos_acc(float a, float& s, float& c) {
    const double ad = (double)a, k = __builtin_rint(ad * 0.63661977236758134308), r = __builtin_fma(-k, 1.57079632679489661923, ad);
    const float x = (float)r, x2 = x * x; const int q = (int)k & 3;
    const float sp = x + x * x2 * ((-1.9515295891e-4f * x2 + 8.3321608736e-3f) * x2 - 1.6666654611e-1f);
    const float cp = 1.0f - 0.5f * x2 + x2 * x2 * ((2.443315711809948e-5f * x2 - 1.388731625493765e-3f) * x2 + 4.166664568298827e-2f);
    s = (q == 0) ? sp : (q == 1) ? cp : (q == 2) ? -sp : -cp;
    c = (q == 0) ? cp : (q == 1) ? -sp : (q == 2) ? -cp : sp;
}
template <class F> __device__ __forceinline__ void tr_item64(const F& f, int K, bf16* WT, int kb, int nb, LAS unsigned* scr, int lane) {
    const int k0 = 64 * kb, n0 = 64 * nb, n4 = lane & 15, kq = lane >> 4;
    const int st = f.col(n0 + 4 * n4);
    f32x4 v[16];
#pragma unroll
    for (int i = 0; i < 16; ++i) v[i] = f.val4(k0 + 16 * kq + i, st);
#pragma unroll
    for (int j = 0; j < 4; ++j) {
        v4u a, b2;
        a.x = pk2(v[0][j], v[1][j]); a.y = pk2(v[2][j], v[3][j]); a.z = pk2(v[4][j], v[5][j]); a.w = pk2(v[6][j], v[7][j]);
        b2.x = pk2(v[8][j], v[9][j]); b2.y = pk2(v[10][j], v[11][j]); b2.z = pk2(v[12][j], v[13][j]); b2.w = pk2(v[14][j], v[15][j]);
        LAS v4u* p = (LAS v4u*)(scr + (4 * n4 + j) * 36 + 8 * kq);
        p[0] = a; p[1] = b2;
    }
    LDS_WAIT(); asm volatile("" ::: "memory");
#pragma unroll
    for (int r = 0; r < 8; ++r) { const int idx = lane + 64 * r, row = idx >> 3, ch = idx & 7;
        const v4u o = *(const LAS v4u*)(scr + row * 36 + 4 * ch);
        *(v4u*)(WT + (size_t)(n0 + row) * K + k0 + 8 * ch) = o; }
    LDS_WAIT(); asm volatile("" ::: "memory");
}
__host__ __device__ __forceinline__ int win_src(int n) {
    if (n < 384) return n;
    if (n < 416) return 640 + (n - 384);
    if (n < 512) return -1;
    if (n < 768) return 384 + (n - 512);
    if (n < 1792) { const int q = n - 768, region = q >> 9, qq = q & 511, c = qq >> 6, w = qq & 63, g = w >> 5, p = w & 31, f = 16 * g + (p & 15) + 32 * (p >> 4);
        return (region ? 1184 : 672) + 64 * c + f; }
    return 1696 + (n - 1792);
}
struct SrcWin { const float* w; const float* g; __device__ __forceinline__ int col(int n) const { return win_src(n); }
    __device__ __forceinline__ f32x4 val4(int k, int st) const { const f32x4 v = *(const f32x4*)(w + (size_t)k * IN_COLS + (st < 0 ? 0 : st)) * g[k]; return st < 0 ? f32x4{} : v; } };
struct SrcScaled { const float* w; const float* g; int N; __device__ __forceinline__ int col(int n) const { return n; }
    __device__ __forceinline__ f32x4 val4(int k, int st) const { return *(const f32x4*)(w + (size_t)k * N + st) * g[k]; } };
struct SrcPlain { const float* w; int N; __device__ __forceinline__ int col(int n) const { return n; }
    __device__ __forceinline__ f32x4 val4(int k, int st) const { return *(const f32x4*)(w + (size_t)k * N + st); } };
struct SrcGU { const float* wg; const float* wu; const float* g; __device__ __forceinline__ int col(int r) const { const int G = r >> 5, p = r & 31; return ((p >> 4) << 16) | (16 * G + (p & 15)); }
    __device__ __forceinline__ f32x4 val4(int k, int st) const { const unsigned long long d = (unsigned long long)wu - (unsigned long long)wg; const float* w = (const float*)((unsigned long long)wg + ((st >> 16) ? d : 0ull));
        return *(const f32x4*)(w + (size_t)k * DFF + (st & 0xffff)) * g[k]; } };

constexpr int I64_IN = 16 * 36, I64_UQ = 6 * 12, I64_UKV = 4 * 16, I64_O = 16 * 16, I64_GU1 = 16 * 8, I64_GU = NEXP * I64_GU1, I64_D1 = 4 * 16, I64_D = NEXP * I64_D1;
constexpr int I64_LATE = I64_UQ + I64_UKV + I64_O + I64_GU + I64_D;
__device__ __forceinline__ void late_weight_item(const In& I, unsigned char* ws, int r, LAS unsigned* scr, int lane) {
    bf16* Wuq_t = (bf16*)(ws + WS_WUQ); bf16* Wukv_t = (bf16*)(ws + WS_WUKV); bf16* Wo_t = (bf16*)(ws + WS_WO); bf16* Wgu_t = (bf16*)(ws + WS_WGU); bf16* Wd_t = (bf16*)(ws + WS_WD);
    if (r < I64_UQ) { SrcScaled f{I.w_uq, I.q_norm_g, 768}; tr_item64(f, QR, Wuq_t, r / 12, r % 12, scr, lane); return; } r -= I64_UQ;
    if (r < I64_UKV) { SrcScaled f{I.w_ukv, I.kv_norm_g, 1024}; tr_item64(f, KVR, Wukv_t, r / 16, r % 16, scr, lane); return; } r -= I64_UKV;
    if (r < I64_O) { SrcPlain f{I.w_o, 1024}; tr_item64(f, 1024, Wo_t, r / 16, r % 16, scr, lane); return; } r -= I64_O;
    if (r < I64_GU) { const int e = r / I64_GU1, q = r % I64_GU1; SrcGU f{I.w_gate + (size_t)e * DM * DFF, I.w_up + (size_t)e * DM * DFF, I.ffn_norm_g}; tr_item64(f, 1024, Wgu_t + (size_t)e * 512 * 1024, q / 8, q % 8, scr, lane); return; } r -= I64_GU;
    { const int e = r / I64_D1, q = r % I64_D1; SrcPlain f{I.w_down + (size_t)e * DFF * DM, 1024}; tr_item64(f, DFF, Wd_t + (size_t)e * 1024 * DFF, q / 16, q % 16, scr, lane); }
}

__device__ __forceinline__ void p0_prologue(const In& I, unsigned char* ws, LAS unsigned char* lds, int vcu, int G, int wave, int lane) {
    LAS unsigned* scr = (LAS unsigned*)(lds + RING_OFF + wave * 16384);
    const int gw = vcu * NWAVES + wave, NGW = G * NWAVES;
    bf16* Win_t = (bf16*)(ws + WS_WIN);
    for (int it = gw; it < I64_IN; it += NGW) { SrcWin f{I.w_in, I.attn_norm_g}; tr_item64(f, 1024, Win_t, it / 36, it % 36, scr, lane); }
    bf16* XB = (bf16*)(ws + WS_XB);
    for (int m = gw; m < T_TOK; m += NGW) {
        const f32x4* xr = (const f32x4*)(I.x + (size_t)m * DM) + lane;
        f32x4 v[4]; float s = 0.f;
#pragma unroll
        for (int j = 0; j < 4; ++j) { v[j] = xr[64 * j]; s += (v[j].x * v[j].x + v[j].y * v[j].y) + (v[j].z * v[j].z + v[j].w * v[j].w); }
        const float rs = 1.0f / sqrtf(wave_sum(s) * (1.0f / DM) + EPS);
        v2u* o8 = (v2u*)(XB + (size_t)m * DM) + lane;
#pragma unroll
        for (int j = 0; j < 4; ++j) { v2u w; w.x = pk2(v[j].x * rs, v[j].y * rs); w.y = pk2(v[j].z * rs, v[j].w * rs); o8[64 * j] = w; }
    }
    { v4u* z = (v4u*)((unsigned*)(ws + WS_CTL) + CW_SSQQ); for (int idx = gw * 64 + lane; idx < 2 * 16384 * 8 / 16; idx += NGW * 64) z[idx] = v4u{0u, 0u, 0u, 0u}; }
    f32x2* cs = (f32x2*)(ws + WS_CS);
    for (int idx = gw * 64 + lane; idx < T_TOK * 32; idx += NGW * 64) {
        const int m = idx >> 5, i = idx & 31;
        const float ang = (float)I.positions[m] * INVF[i];
        float sn, cn; sincos_acc(ang, sn, cn); f32x2 c; c.x = cn; c.y = sn; cs[idx] = c;
    }
    bf16* wrh = (bf16*)(ws + WS_WR); bf16* wrl = wrh + 48 * 1024;
    for (int idx = gw * 64 + lane; idx < 48 * 1024; idx += NGW * 64) {
        const int j = idx >> 10, k = idx & 1023;
        float w = j < 4 ? I.w_rg[k * 4 + j] : (j < 36 ? I.w_re[k * 32 + (j - 4)] : 0.f);
        w *= I.ffn_norm_g[k];
        const unsigned h = f2bf(w); wrh[idx] = (bf16)h; wrl[idx] = (bf16)f2bf(w - bf2f(h));
    }
}

constexpr int RT_PART = 2048, RT_STRIDE = 49, RT_SSQ = RT_PART + 8 * 64 * RT_STRIDE * 4;
static_assert(RT_SSQ + 8 * 64 * 4 <= RING_BYTES, "router LDS");
__device__ __forceinline__ void route_phase(const In& I, const bf16* HB, unsigned char* ws, LAS unsigned char* lds, int vcu, int G, int wave, int lane) {
    LAS unsigned* cnt_l = (LAS unsigned*)(lds + 0); LAS unsigned* base_l = (LAS unsigned*)(lds + 128);
    LAS float* part = (LAS float*)(lds + RT_PART); LAS float* pssq = (LAS float*)(lds + RT_SSQ);
    const bf16* wrh = (const bf16*)(ws + WS_WR); const bf16* wrl = wrh + 48 * 1024;
    unsigned* gcnt = (unsigned*)(ws + WS_CTL) + CW_CNT;
    v4u* rec = (v4u*)(ws + WS_REC); int* TOK = (int*)(ws + WS_TOK); float* GWT = (float*)(ws + WS_GWT); float* RST = (float*)(ws + WS_RST);
    const int tid = wave * 64 + lane, rl = lane & 15, kg = lane >> 4, k0 = 128 * wave + 8 * kg;
    bf16x8 bh[3][4], bl[3][4];
#pragma unroll
    for (int cb = 0; cb < 3; ++cb)
#pragma unroll
        for (int s = 0; s < 4; ++s) { bh[cb][s] = *(const bf16x8*)(wrh + (size_t)(16 * cb + rl) * 1024 + k0 + 32 * s); bl[cb][s] = *(const bf16x8*)(wrl + (size_t)(16 * cb + rl) * 1024 + k0 + 32 * s); }
    for (int grp = vcu; grp < T_TOK / 64; grp += G) {
        const int m0 = 64 * grp;
        if (tid < 32) cnt_l[tid] = 0u;
#pragma unroll 1
        for (int gp = 0; gp < 2; ++gp) {
            bf16x8 a[2][4];
#pragma unroll
            for (int g = 0; g < 2; ++g)
#pragma unroll
                for (int s = 0; s < 4; ++s) a[g][s] = *(const bf16x8*)(HB + (size_t)(m0 + 32 * gp + 16 * g + rl) * DM + k0 + 32 * s);
#pragma unroll
            for (int g = 0; g < 2; ++g) {
                float ss = 0.f; f32x4 acc[3]; acc[0] = f32x4{}; acc[1] = f32x4{}; acc[2] = f32x4{};
#pragma unroll
                for (int s = 0; s < 4; ++s) {
                    const v4u w = __builtin_bit_cast(v4u, a[g][s]);
#pragma unroll
                    for (int j = 0; j < 4; ++j) { const float x0 = bf2f(w[j] & 0xffffu), x1 = bf2f(w[j] >> 16); ss += x0 * x0 + x1 * x1; }
#pragma unroll
                    for (int cb = 0; cb < 3; ++cb) { acc[cb] = __builtin_amdgcn_mfma_f32_16x16x32_bf16(a[g][s], bh[cb][s], acc[cb], 0, 0, 0); acc[cb] = __builtin_amdgcn_mfma_f32_16x16x32_bf16(a[g][s], bl[cb][s], acc[cb], 0, 0, 0); }
                }
                ss += __shfl_xor(ss, 16); ss += __shfl_xor(ss, 32);
                const int tg = 32 * gp + 16 * g;
                if (kg == 0) pssq[wave * 64 + tg + rl] = ss;
#pragma unroll
                for (int cb = 0; cb < 3; ++cb)
#pragma unroll
                    for (int r = 0; r < 4; ++r) part[(wave * 64 + tg + 4 * kg + r) * RT_STRIDE + 16 * cb + rl] = acc[cb][r];
            }
        }
        __syncthreads();
        int e0 = 0, e1 = 0; float w0 = 0.f, w1 = 0.f, rstd = 0.f; unsigned lr0 = 0, lr1 = 0;
        if (wave == 0) {
            float L[36]; float ssq = 0.f;
#pragma unroll
            for (int j = 0; j < 36; ++j) L[j] = 0.f;
#pragma unroll 1
            for (int w = 0; w < 8; ++w) { ssq += pssq[w * 64 + lane];
#pragma unroll
                for (int j = 0; j < 36; ++j) L[j] += part[(w * 64 + lane) * RT_STRIDE + j]; }
            rstd = 1.0f / sqrtf(ssq * (1.0f / DM) + EPS);
            float gl[4];
#pragma unroll
            for (int g = 0; g < 4; ++g) gl[g] = L[g] * rstd + I.b_rg[g];
            int gi = 0; float gm = gl[0];
#pragma unroll
            for (int g = 1; g < 4; ++g) if (gl[g] > gm) { gm = gl[g]; gi = g; }
            float ps = 0.f;
#pragma unroll
            for (int g = 0; g < 4; ++g) ps += __expf(gl[g] - gm);
            const float pg = 1.0f / ps;
            float el[8];
#pragma unroll
            for (int e = 0; e < 8; ++e) { const float raw = gi == 0 ? L[4 + e] : gi == 1 ? L[12 + e] : gi == 2 ? L[20 + e] : L[28 + e]; el[e] = raw * rstd + I.b_re[8 * gi + e]; }
            int i1 = 0; float l1 = el[0];
#pragma unroll
            for (int e = 1; e < 8; ++e) if (el[e] > l1) { l1 = el[e]; i1 = e; }
            int i2 = 0; float l2 = -INFINITY;
#pragma unroll
            for (int e = 0; e < 8; ++e) if (e != i1 && el[e] > l2) { l2 = el[e]; i2 = e; }
            const float ex = __expf(l2 - l1), wn1 = 1.0f / (1.0f + ex), wn2 = ex * wn1;
            e0 = 8 * gi + i1; e1 = 8 * gi + i2; w0 = pg * wn1; w1 = pg * wn2;
            lr0 = __hip_atomic_fetch_add(cnt_l + e0, 1u, __ATOMIC_RELAXED, __HIP_MEMORY_SCOPE_WORKGROUP);
            lr1 = __hip_atomic_fetch_add(cnt_l + e1, 1u, __ATOMIC_RELAXED, __HIP_MEMORY_SCOPE_WORKGROUP);
        }
        __syncthreads();
        if (tid < 32) { const unsigned c = cnt_l[tid]; base_l[tid] = c ? __hip_atomic_fetch_add(gcnt + tid, c, __ATOMIC_RELAXED, __HIP_MEMORY_SCOPE_AGENT) : 0u; }
        __syncthreads();
        if (wave == 0) {
            const unsigned k0r = (base_l[e0] + lr0) & 16383u, k1r = (base_l[e1] + lr1) & 16383u; const int m = m0 + lane;
            v4u r; r.x = (unsigned)e0 | ((unsigned)e1 << 8); r.y = k0r; r.z = k1r; r.w = 0u; rec[m] = r;
            TOK[e0 * 16384 + k0r] = m; GWT[e0 * 16384 + k0r] = w0; RST[e0 * 16384 + k0r] = rstd;
            TOK[e1 * 16384 + k1r] = m; GWT[e1 * 16384 + k1r] = w1; RST[e1 * 16384 + k1r] = rstd;
        }
        __syncthreads();
    }
}

constexpr int MT_PEXP = LDSCTL_OFF + 1024, MT_PBASE = MT_PEXP + 1024, MT_CNT = MT_PBASE + 128, MT_TOKL = LDSCTL_OFF + 4096;
static_assert(MT_TOKL + 3 * 1024 <= LDS_BYTES, "moe LDS");
__device__ __forceinline__ void moe_tables(const unsigned char* ws, LAS unsigned char* ldsall, int wave, int lane) {
    __syncthreads();
    if (wave == 0) {
        const unsigned* gcnt = (const unsigned*)(ws + WS_CTL) + CW_CNT;
        LAS int* pexp = (LAS int*)(ldsall + MT_PEXP); LAS int* pbase = (LAS int*)(ldsall + MT_PBASE); LAS int* cntl = (LAS int*)(ldsall + MT_CNT);
        const unsigned c = lane < 32 ? __hip_atomic_load(gcnt + (lane & 31), RLX_AGENT) : 0u; const unsigned np = (c + 255u) >> 8;
        unsigned incl = np;
#pragma unroll
        for (int o = 1; o < 32; o <<= 1) { const unsigned t = __shfl_up(incl, o); if ((lane & 31) >= o) incl += t; }
        if (lane < 32) { const unsigned pb = incl - np; pbase[lane] = (int)pb; cntl[lane] = (int)c; for (unsigned p = 0; p < np; ++p) if (pb + p < (unsigned)MAXPANEL) pexp[pb + p] = lane; }
        if (lane == 31) pexp[MAXPANEL] = (int)(incl < (unsigned)MAXPANEL ? incl : (unsigned)MAXPANEL);
    }
    __syncthreads();
}

__device__ __forceinline__ void final_phase(const In& I, const bf16* HB, float* out, const unsigned char* ws, LAS unsigned char* ldsall, int vcu, int G, int wave, int lane, float oscale) {
    const v4u* rec = (const v4u*)(ws + WS_REC); const bf16* Y = (const bf16*)(ws + WS_TS);
    const LAS int* pbase = (const LAS int*)(ldsall + MT_PBASE);
    const int pb = pbase[lane & 31] * 256;
    const f32x4* gr = (const f32x4*)I.final_g;
    const f32x4 g0 = gr[2 * lane], g1 = gr[2 * lane + 1], g2 = gr[128 + 2 * lane], g3 = gr[128 + 2 * lane + 1];
    const int gw = vcu * NWAVES + wave, NGW = G * NWAVES;
    for (int mb = 4 * gw; mb < T_TOK; mb += 4 * NGW) {
        const v4u rv = rec[mb + (lane & 3)];
        v4u h[4][2], ya[4][2], yb[4][2];
#pragma unroll
        for (int q = 0; q < 4; ++q) {
            const unsigned ee = __shfl(rv.x, q), k0r = __shfl(rv.y, q), k1r = __shfl(rv.z, q);
            unsigned s0 = (unsigned)__shfl(pb, ee & 31u) + k0r, s1 = (unsigned)__shfl(pb, (ee >> 8) & 31u) + k1r;
            s0 = s0 < (unsigned)MAXSLOT ? s0 : MAXSLOT - 1; s1 = s1 < (unsigned)MAXSLOT ? s1 : MAXSLOT - 1;
            const v4u* hp = (const v4u*)(HB + (size_t)(mb + q) * DM) + lane; const v4u* p0 = (const v4u*)(Y + (size_t)s0 * DM) + lane; const v4u* p1 = (const v4u*)(Y + (size_t)s1 * DM) + lane;
            h[q][0] = hp[0]; h[q][1] = hp[64]; ya[q][0] = p0[0]; ya[q][1] = p0[64]; yb[q][0] = p1[0]; yb[q][1] = p1[64];
        }
#pragma unroll
        for (int q = 0; q < 4; ++q) {
            f32x4 v[4]; float s = 0.f;
#pragma unroll
            for (int hf = 0; hf < 2; ++hf)
#pragma unroll
                for (int j = 0; j < 4; ++j) { const unsigned a = h[q][hf][j], b = ya[q][hf][j], c = yb[q][hf][j];
                    const float x0 = bf2f(a & 0xffffu) + bf2f(b & 0xffffu) + bf2f(c & 0xffffu), x1 = bf2f(a >> 16) + bf2f(b >> 16) + bf2f(c >> 16);
                    v[2 * hf + (j >> 1)][2 * (j & 1)] = x0; v[2 * hf + (j >> 1)][2 * (j & 1) + 1] = x1; s += x0 * x0 + x1 * x1; }
            const float rs = oscale / sqrtf(wave_sum(s) * (1.0f / DM) + EPS);
            f32x4* op = (f32x4*)(out + (size_t)(mb + q) * DM);
            op[2 * lane] = v[0] * rs * g0; op[2 * lane + 1] = v[1] * rs * g1; op[128 + 2 * lane] = v[2] * rs * g2; op[128 + 2 * lane + 1] = v[3] * rs * g3;
        }
    }
}

__global__ void __launch_bounds__(NWAVES * 64, 2) fwd_kernel(Args args) {
    extern __shared__ __attribute__((aligned(16))) unsigned char lds_raw[];
    LAS unsigned char* lds = (LAS unsigned char*)lds_raw;
    volatile LAS unsigned* MISC = (volatile LAS unsigned*)(lds + MISC_OFF);
    const int tid = threadIdx.x, lane = tid & 63, wave = __builtin_amdgcn_readfirstlane(tid >> 6);
    const int G = gridDim.x; const int bx = blockIdx.x; const int vcu = (G % 8 == 0) ? (bx % 8) * (G / 8) + bx / 8 : bx;
    unsigned char* ws = args.ws; const In& I = args.in;
    gu32* ctl = (gu32*)(ws + WS_CTL);
    for (int u = tid; u < (LDS_BYTES - LDSCTL_OFF) / 4; u += NWAVES * 64) ((LAS unsigned*)(lds + LDSCTL_OFF))[u] = 0u;
    __syncthreads();
    XcdBarrier bar; bar.bar = (unsigned*)(ctl + CW_BAR); bar.x = 0; bar.st = nullptr;
    if (N_LAUNCHES != PER_PHASE) bar = xcd_barrier_post((unsigned*)(ctl + CW_BAR), MISC + 8);
    unsigned long long* stamps = (unsigned long long*)(ws + WS_CTL) + CW_STAMP / 2; int n_stamp = 0;
    if (PROBE_PHASE >= 0 && bx == 0 && tid == 0) stamps[0] = __builtin_amdgcn_s_memrealtime();
#define GRID_BAR() do { if (N_LAUNCHES == PER_PHASE) { if (tid == 0) __hip_atomic_store(ctl + CW_TMO, 0xBADBA0u, RLX_AGENT); } else { xcd_barrier(bar); } \
    if (PROBE_PHASE >= 0) { ++n_stamp; if (bx == 0 && tid == 0) stamps[n_stamp] = __builtin_amdgcn_s_memrealtime(); } } while (0)
    const int lo = args.ph_lo, hi = args.ph_hi;
#ifndef PHMASK
#define PHMASK 0x3ff
#endif
#define IN(k) (((PHMASK >> (k)) & 1) && lo <= (k) && (k) < hi)
#define NEXTP(k) ((k) == 5 ? 7 : (k) + 1)
#define BOTH(k) (IN(k) && IN(NEXTP(k)))

    if (IN(0)) { for (int rep = 0; rep < 1 + ((REPEAT_MASK >> 0) & 1); ++rep) { p0_prologue(I, ws, lds, vcu, G, wave, lane); __syncthreads(); } if (BOTH(0)) GRID_BAR(); }

    if (IN(1)) {
        pg8::Gemm g{(const pg8::bf16_t*)(ws + WS_XB), (const pg8::bf16_t*)(ws + WS_WIN), T_TOK, NPROJ, DM};
        pg8::StaticOrder S; S.init(T_TOK, NPROJ, G, bx);
        pg8::EpiProj E{(unsigned long long*)(ctl + CW_SSQQ), (unsigned long long*)(ctl + CW_SSQKV), (const pg8::f32x2e*)(ws + WS_CS), (pg8::bf16_t*)(ws + WS_CQ), (pg8::bf16_t*)(ws + WS_CKV), ws + WS_KM, (pg8::bf16_t*)(ws + WS_DQ), ws + WS_DKI, ws + WS_DVI};
        pg8::gemm_phase<pg8::EpiProj, pg8::StaticOrder, true, true>(lds + RING_OFF, g, S, E);
        { const int nfull = (576 % G) ? (576 % G) : G;
          if (bx >= nfull) { LAS unsigned* scr = (LAS unsigned*)(lds + RING_OFF + wave * 16384); const int nh = (G - nfull) * NWAVES;
              for (int it = (bx - nfull) * NWAVES + wave; it < I64_LATE; it += nh) late_weight_item(I, ws, it, scr, lane); }
          else if (nfull == G) { LAS unsigned* scr = (LAS unsigned*)(lds + RING_OFF + wave * 16384); for (int it = bx * NWAVES + wave; it < I64_LATE; it += G * NWAVES) late_weight_item(I, ws, it, scr, lane); } }
        if (BOTH(1)) GRID_BAR();
    }

    if (IN(2)) {
#ifndef NO_Q
        { pg8::Gemm g{(const pg8::bf16_t*)(ws + WS_CQ), (const pg8::bf16_t*)(ws + WS_WUQ), T_TOK, 768, QR};
          pg8::StaticOrder S; S.init(T_TOK, 768, G, bx);
          pg8::EpiMlaQ E{(const unsigned long long*)(ctl + CW_SSQQ), (const pg8::f32x2e*)(ws + WS_CS), (pg8::bf16_t*)(ws + WS_QM)};
          pg8::gemm_phase<pg8::EpiMlaQ, pg8::StaticOrder, true, true>(lds + RING_OFF, g, S, E); }
#endif
        __syncthreads();
#ifndef NO_KV
        { pg8::Gemm g{(const pg8::bf16_t*)(ws + WS_CKV), (const pg8::bf16_t*)(ws + WS_WUKV), T_TOK, 1024, KVR};
          pg8::StaticOrder S; S.init(T_TOK, 1024, G, (bx + 192) % G);
          pg8::EpiMlaKV E{(const unsigned long long*)(ctl + CW_SSQKV), ws + WS_KM, ws + WS_VM};
          pg8::gemm_phase<pg8::EpiMlaKV, pg8::StaticOrder, true, true>(lds + RING_OFF, g, S, E); }
#endif
        if (BOTH(2)) GRID_BAR();
    }

    if (IN(3)) {
        float lam;
        { const float a = I.lq1[lane] * I.lk1[lane], b = I.lq2[lane] * I.lk2[lane]; lam = expf(wave_sum(a)) - expf(wave_sum(b)) + LAM_INIT; }
        att::AttnArgs A{(const bf16*)(ws + WS_QM), ws + WS_KM, ws + WS_VM, (const bf16*)(ws + WS_DQ), ws + WS_DKI, ws + WS_DVI, (bf16*)(ws + WS_ATT), I.subln_g, lam, (v4u*)(ws + WS_CQ) + (size_t)bx * 4096};
        __syncthreads();
        att::attn_phase<0>(A, lds + RING_OFF, vcu, G, wave, lane);
        if (ATT_VAR) { __syncthreads(); att::attn_phase<ATT_VAR>(A, lds + RING_OFF, vcu, G, wave, lane); }
        if (BOTH(3)) GRID_BAR();
    }

    if (IN(4)) {
        pg8::Gemm g{(const pg8::bf16_t*)(ws + WS_ATT), (const pg8::bf16_t*)(ws + WS_WO), T_TOK, DM, DM};
        pg8::StaticOrder S; S.init(T_TOK, DM, G, bx);
        pg8::EpiWo E{I.x, (pg8::bf16_t*)(ws + WS_HB)};
        pg8::gemm_phase<pg8::EpiWo, pg8::StaticOrder, true, true>(lds + RING_OFF, g, S, E);
        if (BOTH(4)) GRID_BAR();
    }

    if (IN(5)) { __syncthreads(); route_phase(I, (const bf16*)(ws + WS_HB), ws, lds + RING_OFF, vcu, G, wave, lane); if (BOTH(5)) GRID_BAR(); }

    if (IN(7)) {
        moe_tables(ws, lds, wave, lane);
        LAS int* tokl = (LAS int*)(lds + MT_TOKL);
        pg8::MoeOrder S; S.init((const LAS int*)(lds + MT_PEXP), tokl, 2, G, bx);
        { const int* TOK = (const int*)(ws + WS_TOK); const LAS int* pbase = (const LAS int*)(lds + MT_PBASE); const LAS int* cntl = (const LAS int*)(lds + MT_CNT);
          for (int i = 0; i < 3; ++i) { pg8::Unit u; if (!S.next(i, u)) break; const int e = u.pn >> 1, j = u.pm - pbase[e];
              if (tid < 256) { const int rank = 256 * j + tid; tokl[256 * i + tid] = TOK[e * 16384 + (rank < cntl[e] ? rank : 0)] & 16383; } } }
        __syncthreads();
        pg8::Gemm g{(const pg8::bf16_t*)(ws + WS_HB), (const pg8::bf16_t*)(ws + WS_WGU), MAXSLOT, NEXP * 512, DM};
        pg8::EpiGateUp E{(const float*)(ws + WS_GWT), (const float*)(ws + WS_RST), (const LAS int*)(lds + MT_PBASE), (pg8::bf16_t*)(ws + WS_HDN)};
        pg8::gemm_phase<pg8::EpiGateUp, pg8::MoeOrder, true, true, true>(lds + RING_OFF, g, S, E);
        if (BOTH(7)) GRID_BAR();
    }

    if (IN(8)) {
        moe_tables(ws, lds, wave, lane);
        pg8::Gemm g{(const pg8::bf16_t*)(ws + WS_HDN), (const pg8::bf16_t*)(ws + WS_WD), MAXSLOT, NEXP * 1024, DFF};
        pg8::MoeOrder S; S.init((const LAS int*)(lds + MT_PEXP), (const LAS int*)(lds + MT_TOKL), 4, G, bx);
        pg8::EpiDown E{(pg8::bf16_t*)(ws + WS_TS)};
        for (int rep = 0; rep < 1 + ((REPEAT_MASK >> 8) & 1); ++rep) { pg8::gemm_phase<pg8::EpiDown, pg8::MoeOrder, true, true>(lds + RING_OFF, g, S, E); __syncthreads(); }
        if (BOTH(8)) GRID_BAR();
    }

    if (IN(9)) {
        float oscale = 1.0f;
        if (PROBE_PHASE >= 0) { const unsigned long long dt = PROBE_PHASE >= 100 ? stamps[PROBE_PHASE - 100] - stamps[0] : stamps[PROBE_PHASE + 1] - stamps[PROBE_PHASE]; float fr = (float)dt * (PROBE_PHASE >= 100 ? 1.0f / 400000.0f : 1.0f / PROBE_TICKS); fr = fr > 1.f ? 1.f : fr; oscale = 1.0f + sqrtf(2e-3f * fr); }
        moe_tables(ws, lds, wave, lane);
        for (int rep = 0; rep < 1 + ((REPEAT_MASK >> 9) & 1); ++rep) final_phase(I, (const bf16*)(ws + WS_HB), args.out, ws, lds, vcu, G, wave, lane, oscale);
    }
#undef IN
#undef BOTH
#undef GRID_BAR
}

extern "C" void kernel_launch(void* const* d_in, const int* in_sizes, int n_in, void* d_out, int out_size, void* d_ws, size_t ws_size, hipStream_t stream) {
    static int grid = 0;
    if (grid == 0) {
        if (n_in != 23 || in_sizes[0] != T_TOK * DM || out_size != T_TOK * DM || ws_size < WS_END) { fprintf(stderr, "kernel_launch: unexpected problem shape (n_in %d, in0 %d, out %d, ws %zu)\n", n_in, n_in > 0 ? in_sizes[0] : -1, out_size, ws_size); grid = -1; return; }
        int dev = 0, cus = 0, per_cu = 0;
        if (hipGetDevice(&dev) != hipSuccess || hipDeviceGetAttribute(&cus, hipDeviceAttributeMultiprocessorCount, dev) != hipSuccess) { grid = -1; return; }
        if (hipFuncSetAttribute((const void*)fwd_kernel, hipFuncAttributeMaxDynamicSharedMemorySize, LDS_BYTES) != hipSuccess) { fprintf(stderr, "kernel_launch: hipFuncSetAttribute failed\n"); grid = -1; return; }
        if (hipOccupancyMaxActiveBlocksPerMultiprocessor(&per_cu, (const void*)fwd_kernel, NWAVES * 64, LDS_BYTES) != hipSuccess || per_cu < 1) { fprintf(stderr, "kernel_launch: occupancy query says %d blocks per CU\n", per_cu); }
        (void)hipGetLastError();
        grid = cus;
    }
    if (grid < 0) return;
    if (hipMemsetAsync((char*)d_ws + WS_CTL, 0, CTL_ZERO_BYTES, stream) != hipSuccess) { fprintf(stderr, "kernel_launch: memset failed\n"); return; }
    Args a{};
    const void** ip = (const void**)&a.in;
    for (int i = 0; i < 23; ++i) ip[i] = d_in[i];
    a.out = (float*)d_out; a.ws = (unsigned char*)d_ws;
    if (N_LAUNCHES == 1) {
        a.ph_lo = 0; a.ph_hi = PER_PHASE; a.li = 0;
        hipLaunchKernelGGL(fwd_kernel, dim3(grid), dim3(NWAVES * 64), LDS_BYTES, stream, a);
    } else {
        for (int li = 0; li < PER_PHASE; ++li) { a.ph_lo = li; a.ph_hi = li + 1; a.li = li; hipLaunchKernelGGL(fwd_kernel, dim3(grid), dim3(NWAVES * 64), LDS_BYTES, stream, a); }
    }
    const hipError_t le = hipPeekAtLastError();
    if (le != hipSuccess) fprintf(stderr, "kernel_launch: launch failed: %s\n", hipGetErrorName(le));
}
```

```cpp
#include <hip/hip_runtime.h>
#include <cstdio>
#include <cstdint>

#ifndef PROBE_PHASE
#define PROBE_PHASE -1
#endif
#ifndef PROBE_TICKS
#define PROBE_TICKS 50000.0f
#endif
#ifndef ATT_VAR
#define ATT_VAR 0
#endif
#ifndef PRETOUCH
#define PRETOUCH 0
#endif
#ifndef REPEAT_MASK
#define REPEAT_MASK 0
#endif
#ifndef MK_N_LAUNCHES
#define MK_N_LAUNCHES 1
#endif

constexpr int NB = 8, SEQ = 2048, DM = 1024, T_TOK = NB * SEQ;
constexpr int IN_COLS = 2208, NPROJ = 2304;
constexpr int QR = 384, KVR = 256;
constexpr int NEXP = 32, DFF = 256;
constexpr int MAXPANEL = 160, MAXSLOT = MAXPANEL * 256;
constexpr float EPS = 1e-6f;
constexpr float LOG2E = 1.4426950408889634f;
constexpr float QSCALE_M = 0.10206207261596577f * LOG2E;
constexpr float QSCALE_D = 0.125f * LOG2E;
constexpr float LAM_INIT = 0.2f;

constexpr size_t MiB = 1u << 20;
constexpr size_t WS_CTL = 0, CTL_BYTES = 1 * MiB, CTL_ZERO_BYTES = 64 * 1024;
constexpr size_t WS_WIN = 1 * MiB;
constexpr size_t WS_WUQ = 6 * MiB;
constexpr size_t WS_WUKV = 7 * MiB;
constexpr size_t WS_WO = 8 * MiB;
constexpr size_t WS_WGU = 10 * MiB;
constexpr size_t WS_WD = 42 * MiB;
constexpr size_t WS_CS = 58 * MiB;
constexpr size_t WS_WR = 62 * MiB;
constexpr size_t WS_REC = 62 * MiB + 256 * 1024;
constexpr size_t WS_GW = 63 * MiB;
constexpr size_t WS_PEXP = 63 * MiB + 256 * 1024;
constexpr size_t WS_XB = 64 * MiB;
constexpr size_t WS_ATT = WS_XB;
constexpr size_t WS_CQ = 96 * MiB;
constexpr size_t WS_CKV = 108 * MiB;
constexpr size_t WS_QM = 116 * MiB;
constexpr size_t WS_KM = 140 * MiB;
constexpr size_t WS_VM = 164 * MiB;
constexpr size_t WS_DQ = 180 * MiB;
constexpr size_t WS_DKI = 196 * MiB;
constexpr size_t WS_DVI = 212 * MiB;
constexpr size_t WS_TS = 96 * MiB;
constexpr size_t WS_HB = 196 * MiB;
constexpr size_t WS_TOK = 64 * MiB;
constexpr size_t WS_GWT = 66 * MiB, WS_RST = 68 * MiB;
constexpr size_t WS_HDN = 176 * MiB;
constexpr size_t WS_END = 228 * MiB;
constexpr int CW_TMO = 0;
constexpr int CW_BAR = 4096;
constexpr int CW_STAMP = 12288;
constexpr int CW_CNT = 8192;
constexpr int CW_SSQQ = 16384;
constexpr int CW_SSQKV = 49152;
static_assert((CW_SSQKV + 32768) * 4 <= (int)CTL_BYTES && (CW_STAMP + 64) * 4 <= (int)CTL_ZERO_BYTES && CW_SSQQ * 4 >= (int)CTL_ZERO_BYTES, "ctl");

constexpr int RING_OFF = 0, RING_BYTES = 131072;
constexpr int LDS_BYTES = 163840;
constexpr int LDSCTL_OFF = LDS_BYTES - 8192, MISC_OFF = LDSCTL_OFF + 320;

#define GAS __attribute__((address_space(1)))
#define LAS __attribute__((address_space(3)))
typedef unsigned short bf16;
typedef unsigned v4u __attribute__((ext_vector_type(4)));
typedef unsigned v2u __attribute__((ext_vector_type(2)));
typedef float f32x4 __attribute__((ext_vector_type(4)));
typedef float f32x2 __attribute__((ext_vector_type(2)));
typedef float f32x16 __attribute__((ext_vector_type(16)));
typedef short bf16x8 __attribute__((ext_vector_type(8)));
typedef short s16x4 __attribute__((ext_vector_type(4)));
typedef GAS unsigned gu32;
#define RLX_AGENT __ATOMIC_RELAXED, __HIP_MEMORY_SCOPE_AGENT
#define LDS_WAIT() asm volatile("s_waitcnt lgkmcnt(0)" ::: "memory")
#define VM_WAIT() asm volatile("s_waitcnt vmcnt(0)" ::: "memory")
__device__ __forceinline__ unsigned f2bf(float f) { unsigned u = __builtin_bit_cast(unsigned, f); return (u + 0x7fffu + ((u >> 16) & 1u)) >> 16; }
__device__ __forceinline__ unsigned pk2(float lo, float hi) { return f2bf(lo) | (f2bf(hi) << 16); }
__device__ __forceinline__ float bf2f(unsigned b) { return __builtin_bit_cast(float, b << 16); }
typedef __bf16 bf16x2_t __attribute__((ext_vector_type(2)));
__device__ __forceinline__ unsigned cvtpk(float lo, float hi) { f32x2 v = {lo, hi}; bf16x2_t b = __builtin_convertvector(v, bf16x2_t); return __builtin_bit_cast(unsigned, b); }
__device__ __forceinline__ v2u pack4(f32x4 v) { v2u r; r.x = cvtpk(v[0], v[1]); r.y = cvtpk(v[2], v[3]); return r; }
__device__ __forceinline__ float wave_sum(float v) {
#pragma unroll
    for (int o = 1; o < 64; o <<= 1) v += __shfl_xor(v, o);
    return v;
}

#define XB_TMO      128
#define XB_XCNT(j)  (256  + 64 * (j))
#define XB_XSUB(j)  (1280 + 64 * (j))
#define XB_XGEN(j)  (2304 + 64 * (j))
#define XB_TOP      3328
#define XB_TOPGEN   3392
#define XCD_BAR_WORDS 3456
#define XB_SPIN_CAP (1u << 18)
__device__ __forceinline__ unsigned xb_ld(unsigned* p)              { return __hip_atomic_load(p, __ATOMIC_RELAXED, __HIP_MEMORY_SCOPE_AGENT); }
__device__ __forceinline__ unsigned xb_add(unsigned* p, unsigned v) { return __hip_atomic_fetch_add(p, v, __ATOMIC_RELAXED, __HIP_MEMORY_SCOPE_AGENT); }
__device__ __forceinline__ unsigned xb_xcc_id() { return (unsigned)__builtin_amdgcn_s_getreg((3 << 11) | 20) & 0xFu; }
#define XB_SPIN(cond, bar) do { unsigned _sp = 0; while (cond) { __builtin_amdgcn_s_sleep(1); \
    if ((++_sp & 255u) == 0u) { if (xb_ld(&(bar)[XB_TMO])) break; if (_sp > XB_SPIN_CAP) { atomicAdd(&(bar)[XB_TMO], 1u); break; } } } } while (0)
struct XcdBarrier { unsigned* bar; unsigned x; volatile LAS unsigned* st; };
__device__ __forceinline__ XcdBarrier xcd_barrier_post(unsigned* bar, volatile LAS unsigned* st) {
    XcdBarrier b; b.bar = bar; b.x = xb_xcc_id(); b.st = st;
    if (threadIdx.x == 0) (void)xb_add(&bar[XB_XCNT(b.x)], 1u);
    return b;
}
__device__ __forceinline__ void xcd_barrier_complete(unsigned* bar, unsigned x, unsigned& nloc, unsigned& nx) {
    const unsigned G = gridDim.x * gridDim.y * gridDim.z;
    unsigned sum, cnt, mine, sp = 0u;
    for (;;) {
        sum = 0u; cnt = 0u; mine = 0u;
#pragma unroll
        for (unsigned j = 0; j < 16; ++j) { const unsigned c = xb_ld(&bar[XB_XCNT(j)]); sum += c; cnt += (c > 0u) ? 1u : 0u; mine = (j == x) ? c : mine; }
        if (sum == G) break;
        __builtin_amdgcn_s_sleep(1);
        if ((++sp & 255u) == 0u) { if (xb_ld(&bar[XB_TMO])) break; if (sp > XB_SPIN_CAP) { atomicAdd(&bar[XB_TMO], 1u); break; } }
    }
    nloc = mine > 0u ? mine : 1u; nx = cnt > 0u ? cnt : 1u;
}
__device__ __forceinline__ void xcd_barrier(const XcdBarrier& b) {
    asm volatile("s_waitcnt vmcnt(0)" ::: "memory");
    __syncthreads();
    if (threadIdx.x == 0) {
        unsigned* bar = b.bar;
        __builtin_amdgcn_s_waitcnt(0);
        unsigned nloc = b.st[0], nx = b.st[1];
        if (nloc == 0u) { xcd_barrier_complete(bar, b.x, nloc, nx); b.st[0] = nloc; b.st[1] = nx; }
        const unsigned old = xb_add(&bar[XB_XSUB(b.x)], 1u);
        const unsigned gen = old / nloc;
        if (old + 1u == (gen + 1u) * nloc) {
            __builtin_amdgcn_fence(__ATOMIC_RELEASE, "agent");
            asm volatile("s_waitcnt vmcnt(0)" ::: "memory");
            const unsigned og = xb_add(&bar[XB_TOP], 1u);
            const unsigned tg = og / nx;
            if (og + 1u == (tg + 1u) * nx) xb_add(&bar[XB_TOPGEN], 1u);
            else XB_SPIN(xb_ld(&bar[XB_TOPGEN]) == tg, bar);
            __builtin_amdgcn_fence(__ATOMIC_ACQUIRE, "agent");
            xb_add(&bar[XB_XGEN(b.x)], 1u);
            asm volatile("s_waitcnt vmcnt(0)" ::: "memory");
        } else {
            XB_SPIN(xb_ld(&bar[XB_XGEN(b.x)]) == gen, bar);
            __builtin_amdgcn_fence(__ATOMIC_ACQUIRE, "agent");
            asm volatile("s_waitcnt vmcnt(0)" ::: "memory");
        }
    }
    __syncthreads();
}
namespace pg8 {
#define PG8_LAS __attribute__((address_space(3)))
typedef unsigned short bf16_t;
typedef short bf16x8 __attribute__((ext_vector_type(8)));
typedef float f32x4 __attribute__((ext_vector_type(4)));
typedef unsigned u32x4 __attribute__((ext_vector_type(4)));
constexpr int BM = 256, BK = 64, HALF = 128, HTB = HALF * BK * 2  , STAGE_BYTES = 8 * HTB, NXCD = 8, WGM = 8;

__host__ __device__ __forceinline__ int lds_byte(int r, int c) { const int st = (r >> 4) * 2 + (c >> 5), rr = r & 15, cc = c & 31, ob = rr * 64 + cc * 2; return st * 1024 + (ob ^ (((ob >> 9) & 1) << 5)); }
__host__ __device__ __forceinline__ void stage_rc(int b, int& R, int& C) { const int st = b / 1024, sb = b % 1024, swz = sb ^ (((sb >> 9) & 1) << 5); R = (st >> 1) * 16 + swz / 64; C = (st & 1) * 32 + (swz % 64) / 2; }
__host__ __device__ __forceinline__ int perm32(int rho) { const int n = rho >> 4, i = rho & 15; return 8 * (i >> 2) + 4 * n + (i & 3); }

struct Unit { int pm, pn; };
struct Gemm { const bf16_t* A; const bf16_t* Bt; int M, N, K; };

struct StaticOrder {
    int nM, nN, nwg, G, c;
    __host__ __device__ void init(int M, int N, int G_, int c_) { nM = M / BM; nN = N / BM; nwg = nM * nN; G = G_; c = c_; }
    __host__ __device__ bool next(int i, Unit& u) const {
        const long L = (long)i * G + c; if (L >= nwg) return false;
        int wgid = (int)L; { const int q = nwg / NXCD, r = nwg % NXCD, xcd = wgid % NXCD, off = wgid / NXCD; wgid = (xcd < r ? xcd * (q + 1) : r * (q + 1) + (xcd - r) * q) + off; }
        const int nig = WGM * nN, gid = wgid / nig, fm = gid * WGM, gsz = (nM - fm) < WGM ? (nM - fm) : WGM;
        u.pm = fm + ((wgid % nig) % gsz); u.pn = (wgid % nig) / gsz; return true;
    }
    __device__ __forceinline__ void a_ready(const Unit&) const {}
    __device__ __forceinline__ void done(const Unit&) const {}
};


typedef float f32x2e __attribute__((ext_vector_type(2)));
typedef unsigned u32x2e __attribute__((ext_vector_type(2)));
__device__ __forceinline__ unsigned cvtpk_e(float lo, float hi) { typedef __bf16 b2 __attribute__((ext_vector_type(2))); f32x2e v = {lo, hi}; b2 b = __builtin_convertvector(v, b2); return __builtin_bit_cast(unsigned, b); }
__device__ __forceinline__ u32x2e pack4e(f32x4 v) { u32x2e r; r.x = cvtpk_e(v[0], v[1]); r.y = cvtpk_e(v[2], v[3]); return r; }

struct EpiProj {
    static constexpr bool PERM = false, AFTER_DRAIN = false;
    unsigned long long* ssq_q; unsigned long long* ssq_kv; const f32x2e* cs;
    bf16_t* CQ; bf16_t* CKV; unsigned char* KM; bf16_t* DQ; unsigned char* DKI; unsigned char* DVI;
    __device__ __forceinline__ void operator()(const f32x4 (&acc)[2][2][4][2], const Unit& u, int wr, int wc, int fr, int fq) const {
        const int pn = u.pn;
        const int row0 = u.pm * BM + wr * 64 + fr;
        if (pn <= 2) {
#pragma unroll
            for (int ai = 0; ai < 2; ++ai)
#pragma unroll
                for (int m = 0; m < 4; ++m) {
                    const int row = row0 + ai * HALF + m * 16; float s = 0.f;
#pragma unroll
                    for (int bj = 0; bj < 2; ++bj) {
                        if (pn == 1 && bj == 1) continue;
#pragma unroll
                        for (int n = 0; n < 2; ++n) {
                            const f32x4 v = acc[ai][bj][m][n]; s += (v[0] * v[0] + v[1] * v[1]) + (v[2] * v[2] + v[3] * v[3]);
                            const int col = bj * HALF + wc * 32 + n * 16 + fq * 4;
                            if (pn == 2) *(u32x2e*)(CKV + (size_t)row * 256 + col) = pack4e(v);
                            else *(u32x2e*)(CQ + (size_t)row * 384 + pn * 256 + col) = pack4e(v);
                        }
                    }
                    s += __shfl_xor(s, 16); s += __shfl_xor(s, 32);
                    if (fq == 0) atomicAdd((pn == 2 ? ssq_kv : ssq_q) + row, (unsigned long long)(s * 4294967296.0f));
                }
            if (pn == 1 && wc == 0) {
#pragma unroll
                for (int ai = 0; ai < 2; ++ai)
#pragma unroll
                    for (int m = 0; m < 4; ++m) {
                        const int row = row0 + ai * HALF + m * 16;
                        const f32x4 x1 = acc[ai][1][m][0], x2 = acc[ai][1][m][1];
                        f32x4 o1, o2;
#pragma unroll
                        for (int i = 0; i < 4; ++i) { const f32x2e c = cs[(size_t)row * 32 + 2 * (4 * fq + i)]; o1[i] = x1[i] * c.x - x2[i] * c.y; o2[i] = x2[i] * c.x + x1[i] * c.y; }
                        const int b = row >> 11, sq = row & 2047, t = sq >> 6, kr = sq & 63;
                        const u32x2e w1 = pack4e(o1), w2 = pack4e(o2);
#pragma unroll
                        for (int h = 0; h < 8; ++h) {
                            unsigned char* base = KM + ((size_t)((b * 8 + h) * 32 + t)) * 12288 + kr * 16 + (fq & 1) * 8;
                            *(u32x2e*)(base + (8 + (fq >> 1)) * 1024) = w1;
                            *(u32x2e*)(base + (10 + (fq >> 1)) * 1024) = w2;
                        }
                    }
            }
        } else if (pn <= 6) {
            const int g = wc & 1; const bool isq = pn <= 4; const int pt = isq ? pn - 3 : pn - 5;
#pragma unroll
            for (int ai = 0; ai < 2; ++ai)
#pragma unroll
                for (int m = 0; m < 4; ++m) {
                    const int row = row0 + ai * HALF + m * 16;
                    const int f1 = 16 * g + 4 * fq;
                    const f32x4 cA = *(const f32x4*)(cs + (size_t)row * 32 + f1), cB = *(const f32x4*)(cs + (size_t)row * 32 + f1 + 2);
                    const int b = row >> 11, sq = row & 2047, t = sq >> 6, kr = sq & 63;
#pragma unroll
                    for (int bj = 0; bj < 2; ++bj) {
                        const int chunk = 4 * pt + 2 * bj + (wc >> 1);
                        const f32x4 x1 = acc[ai][bj][m][0], x2 = acc[ai][bj][m][1];
                        f32x4 o1, o2;
                        o1[0] = x1[0] * cA[0] - x2[0] * cA[1]; o2[0] = x2[0] * cA[0] + x1[0] * cA[1];
                        o1[1] = x1[1] * cA[2] - x2[1] * cA[3]; o2[1] = x2[1] * cA[2] + x1[1] * cA[3];
                        o1[2] = x1[2] * cB[0] - x2[2] * cB[1]; o2[2] = x2[2] * cB[0] + x1[2] * cB[1];
                        o1[3] = x1[3] * cB[2] - x2[3] * cB[3]; o2[3] = x2[3] * cB[2] + x1[3] * cB[3];
                        if (isq) {
                            o1 = o1 * QSCALE_D; o2 = o2 * QSCALE_D;
                            bf16_t* p = DQ + (size_t)row * 512 + chunk * 64 + f1;
                            *(u32x2e*)p = pack4e(o1); *(u32x2e*)(p + 32) = pack4e(o2);
                        } else {
                            unsigned char* base = DKI + ((size_t)((b * 8 + chunk) * 32 + t)) * 8192 + kr * 16 + (fq & 1) * 8 + (2 * g + (fq >> 1)) * 1024;
                            *(u32x2e*)base = pack4e(o1); *(u32x2e*)(base + 4096) = pack4e(o2);
                        }
                    }
                }
        } else {
#pragma unroll
            for (int ai = 0; ai < 2; ++ai)
#pragma unroll
                for (int m = 0; m < 4; ++m) {
                    const int row = row0 + ai * HALF + m * 16;
                    const int b = row >> 11, sq = row & 2047, t = sq >> 6, kr = sq & 63;
#pragma unroll
                    for (int bj = 0; bj < 2; ++bj) {
                        const int h4 = 2 * (pn - 7) + bj;
                        unsigned char* base = DVI + ((size_t)((b * 4 + h4) * 32 + t)) * 16384 + wc * 4096 + kr * 64 + fq * 8;
#pragma unroll
                        for (int n = 0; n < 2; ++n) *(u32x2e*)(base + n * 32) = pack4e(acc[ai][bj][m][n]);
                    }
                }
        }
    }
};

struct EpiMlaQ {
    static constexpr bool PERM = false, AFTER_DRAIN = false;
    const unsigned long long* ssq_q; const f32x2e* cs; bf16_t* QM;
    __device__ __forceinline__ void operator()(const f32x4 (&acc)[2][2][4][2], const Unit& u, int wr, int wc, int fr, int fq) const {
        const int row0 = u.pm * BM + wr * 64 + fr;
        int hh[2], pp[2];
#pragma unroll
        for (int bj = 0; bj < 2; ++bj) { const int G = 8 * u.pn + 4 * bj + wc; hh[bj] = G / 3; pp[bj] = G - 3 * hh[bj]; }
#pragma unroll
        for (int ai = 0; ai < 2; ++ai)
#pragma unroll
            for (int m = 0; m < 4; ++m) {
                const int row = row0 + ai * HALF + m * 16;
                const float rs = __builtin_amdgcn_rsqf((float)ssq_q[row] * (2.3283064365386963e-10f / 384.0f) + EPS) * QSCALE_M;
#pragma unroll
                for (int bj = 0; bj < 2; ++bj) {
                    bf16_t* p = QM + ((unsigned)row * 768u + (unsigned)(hh[bj] * 96 + pp[bj] * 32 + fq * 4));
                    if (pp[bj] < 2) {
#pragma unroll
                        for (int n = 0; n < 2; ++n) *(u32x2e*)(p + n * 16) = pack4e(acc[ai][bj][m][n] * rs);
                    } else {
                        const f32x4 x1 = acc[ai][bj][m][0] * rs, x2 = acc[ai][bj][m][1] * rs; f32x4 o1, o2;
                        const f32x2e* cp = cs + ((unsigned)row * 32u + 8u * (unsigned)fq);
#pragma unroll
                        for (int i = 0; i < 4; ++i) { const f32x2e c = cp[2 * i]; o1[i] = x1[i] * c.x - x2[i] * c.y; o2[i] = x2[i] * c.x + x1[i] * c.y; }
                        *(u32x2e*)p = pack4e(o1); *(u32x2e*)(p + 16) = pack4e(o2);
                    }
                }
                asm volatile("" ::: "memory");
            }
    }
};
struct EpiMlaKV {
    static constexpr bool PERM = false, AFTER_DRAIN = false;
    const unsigned long long* ssq_kv; unsigned char* KM; unsigned char* VM;
    __device__ __forceinline__ void operator()(const f32x4 (&acc)[2][2][4][2], const Unit& u, int wr, int wc, int fr, int fq) const {
        const int row0 = u.pm * BM + wr * 64 + fr;
        const int G0 = 8 * u.pn + wc, h0 = G0 >> 2, part = G0 & 3;
        const bool isk = part < 2;
        unsigned char* const B = isk ? KM : VM;
        const unsigned tile_b = isk ? 12288u : 8192u;
        const unsigned lane_off = isk ? (unsigned)((fq & 1) * 8 + (4 * part + (fq >> 1)) * 1024) : (unsigned)((part - 2) * 4096 + fq * 8);
        const unsigned row_b = isk ? 16u : 64u, n_b = isk ? 2048u : 32u;
#pragma unroll
        for (int ai = 0; ai < 2; ++ai)
#pragma unroll
            for (int m = 0; m < 4; ++m) {
                const int row = row0 + ai * HALF + m * 16;
                const float rs = __builtin_amdgcn_rsqf((float)ssq_kv[row] * (2.3283064365386963e-10f / 256.0f) + EPS);
                const unsigned b = (unsigned)row >> 11, sq = (unsigned)row & 2047u, t = sq >> 6, kr = sq & 63u;
#pragma unroll
                for (int bj = 0; bj < 2; ++bj) {
                    const unsigned off = ((b * 8u + (unsigned)(h0 + bj)) * 32u + t) * tile_b + kr * row_b + lane_off;
#pragma unroll
                    for (int n = 0; n < 2; ++n) *(u32x2e*)(B + off + n * n_b) = pack4e(acc[ai][bj][m][n] * rs);
                }
                asm volatile("" ::: "memory");
            }
    }
};
struct EpiWo {
    static constexpr bool PERM = false, AFTER_DRAIN = false;
    const float* x; bf16_t* HB;
    __device__ __forceinline__ void operator()(const f32x4 (&acc)[2][2][4][2], const Unit& u, int wr, int wc, int fr, int fq) const {
        const int row0 = u.pm * BM + wr * 64 + fr, col0 = u.pn * BM + wc * 32 + 4 * fq;
#pragma unroll
        for (int ai = 0; ai < 2; ++ai)
#pragma unroll
            for (int m = 0; m < 4; ++m) { const unsigned off = (unsigned)(row0 + ai * HALF + m * 16) * 1024u + (unsigned)col0;
#pragma unroll
                for (int bj = 0; bj < 2; ++bj)
#pragma unroll
                    for (int n = 0; n < 2; ++n) *(u32x2e*)(HB + off + bj * HALF + n * 16) = pack4e(*(const f32x4*)(x + off + bj * HALF + n * 16) + acc[ai][bj][m][n]);
                asm volatile("" ::: "memory"); }
    }
};
struct EpiGateUp {
    static constexpr bool PERM = false, AFTER_DRAIN = false;
    const float* GWT; const float* RST; const PG8_LAS int* pbase; bf16_t* HDN;
    __device__ __forceinline__ void operator()(const f32x4 (&acc)[2][2][4][2], const Unit& u, int wr, int wc, int fr, int fq) const {
        const int e = u.pn >> 1, pl = u.pn & 1, j = u.pm - __builtin_amdgcn_readfirstlane(pbase[e]);
        const int r0 = wr * 64 + fr; const unsigned ib = (unsigned)(e * 16384 + 256 * j);
#pragma unroll
        for (int ai = 0; ai < 2; ++ai)
#pragma unroll
            for (int m = 0; m < 4; ++m) {
                const int r = r0 + ai * HALF + m * 16; const float gw = GWT[ib + r], rs = RST[ib + r];
#pragma unroll
                for (int bj = 0; bj < 2; ++bj) {
                    const f32x4 a = acc[ai][bj][m][0] * rs, uu = acc[ai][bj][m][1] * (rs * gw); f32x4 o;
#pragma unroll
                    for (int i = 0; i < 4; ++i) { const float sg = __builtin_amdgcn_rcpf(1.0f + __builtin_amdgcn_exp2f(-a[i] * LOG2E)); o[i] = a[i] * sg * uu[i]; }
                    *(u32x2e*)(HDN + (unsigned)(u.pm * BM + r) * 256u + (unsigned)(16 * (8 * pl + 4 * bj + wc) + 4 * fq)) = pack4e(o);
                }
                asm volatile("" ::: "memory");
            }
    }
};
struct EpiDown {
    static constexpr bool PERM = false, AFTER_DRAIN = false;
    bf16_t* Y;
    __device__ __forceinline__ void operator()(const f32x4 (&acc)[2][2][4][2], const Unit& u, int wr, int wc, int fr, int fq) const {
        const int row0 = u.pm * BM + wr * 64 + fr, col0 = (u.pn & 3) * BM + wc * 32 + 4 * fq;
#pragma unroll
        for (int ai = 0; ai < 2; ++ai)
#pragma unroll
            for (int m = 0; m < 4; ++m) { const size_t off = (size_t)(row0 + ai * HALF + m * 16) * 1024 + col0;
#pragma unroll
                for (int bj = 0; bj < 2; ++bj)
#pragma unroll
                    for (int n = 0; n < 2; ++n) *(u32x2e*)(Y + off + bj * HALF + n * 16) = pack4e(acc[ai][bj][m][n]); }
    }
};
struct MoeOrder {
    const PG8_LAS int* pexp; const PG8_LAS int* tokl; int npan, ntn, G, vc;
    __device__ __forceinline__ void init(const PG8_LAS int* pexp_, const PG8_LAS int* tokl_, int ntn_, int G_, int bx) { pexp = pexp_; tokl = tokl_; ntn = ntn_; G = G_; vc = (G_ % 8 == 0) ? (bx % 8) * (G_ / 8) + bx / 8 : bx;
        npan = __builtin_amdgcn_readfirstlane(pexp_[MAXPANEL]); if (npan > MAXPANEL) npan = MAXPANEL; if (npan < 0) npan = 0; }
    __device__ __forceinline__ bool next(int i, Unit& u) const {
        const int L = i * G + vc; if (L >= npan * ntn) return false;
        const int p = L / ntn, pl = L - p * ntn; const int e = __builtin_amdgcn_readfirstlane(pexp[p]) & 31;
        u.pm = p; u.pn = e * ntn + pl; return true;
    }
    __device__ __forceinline__ const PG8_LAS int* toks(int ui) const { return tokl + 256 * ui; }
    __device__ __forceinline__ void a_ready(const Unit&) const {}
    __device__ __forceinline__ void done(const Unit&) const {}
};
template <class Epi, class Sched, bool ALIGN_EPI = false, bool SP2 = false, bool GATHER = false>
__device__ __forceinline__ void gemm_phase(PG8_LAS unsigned char* lds, const Gemm g, const Sched& S, const Epi& E) {
    const int tid = threadIdx.x, wid = __builtin_amdgcn_readfirstlane(tid >> 6), lane = tid & 63, wr = wid >> 2, wc = wid & 3, fr = lane & 15, fq = lane >> 4;
    int K_ = g.K; asm volatile("" : "+s"(K_));
    const int K = K_, nt = K / BK;
    static_assert(!GATHER || SP2, "row gather is implemented on the SP2 loop only");
    unsigned voffA[2], voffB[2]; int gR0 = 0, gR1 = 0; unsigned gC0 = 0, gC1 = 0;
#pragma unroll
    for (int i = 0; i < 2; ++i) { int R, C; stage_rc(tid * 16 + i * 8192, R, C); const int Rb = Epi::PERM ? ((R & ~31) + perm32(R & 31)) : R;
        voffA[i] = (unsigned)(R * K + C) * 2u; voffB[i] = (unsigned)(Rb * K + C) * 2u; if (i == 0) { gR0 = R; gC0 = (unsigned)C * 2u; } else { gR1 = R; gC1 = (unsigned)C * 2u; } }
    const size_t kstep = (size_t)(BK * 2);
    const size_t hstep = (size_t)HALF * K * 2;
    const size_t tstep = 2 * hstep;
    const unsigned ldsw = (unsigned)wid * 1024u;
    const int aoff = lds_byte(wr * 64 + fr, fq * 8), boff = lds_byte(wc * 32 + fr, fq * 8);
#define PG8_SA(b, h) (((b) * 2 + (h)) * HTB)
#define PG8_SB(b, h) ((4 + (b) * 2 + (h)) * HTB)
#define PG8_STAGE(bufoff, gbase, voff) do { _Pragma("unroll") for (int _i = 0; _i < 2; ++_i) \
        __builtin_amdgcn_global_load_lds((const unsigned*)((const char*)(gbase) + (voff)[_i]), (PG8_LAS unsigned*)(lds + (bufoff) + ldsw + _i * 8192), 16, 0, 0); } while (0)
#define PG8_STAGE2(bufoff, gbase, v0, v1) do { \
        __builtin_amdgcn_global_load_lds((const unsigned*)((const char*)(gbase) + (v0)), (PG8_LAS unsigned*)(lds + (bufoff) + ldsw), 16, 0, 0); \
        __builtin_amdgcn_global_load_lds((const unsigned*)((const char*)(gbase) + (v1)), (PG8_LAS unsigned*)(lds + (bufoff) + ldsw + 8192), 16, 0, 0); } while (0)
#define PG8_STAGE_A(bufoff, gbase, h, nx) do { if constexpr (GATHER) { PG8_STAGE2(bufoff, gbase, (nx) ? gN##h##0 : gA##h##0, (nx) ? gN##h##1 : gA##h##1); } else { PG8_STAGE(bufoff, (gbase) + (h) * hstep, voffA); } } while (0)
#define PG8_GLOAD(P, tl) do { const PG8_LAS int* tl_ = (tl); const unsigned kb_ = (unsigned)K * 2u; \
        P##00 = (unsigned)tl_[gR0] * kb_ + gC0; P##01 = (unsigned)tl_[gR1] * kb_ + gC1; P##10 = (unsigned)tl_[HALF + gR0] * kb_ + gC0; P##11 = (unsigned)tl_[HALF + gR1] * kb_ + gC1; } while (0)
#define PG8_LDA(dst, b, h) do { _Pragma("unroll") for (int m = 0; m < 4; ++m) _Pragma("unroll") for (int k = 0; k < 2; ++k) dst[m][k] = *(const PG8_LAS bf16x8*)(lds + PG8_SA(b, h) + aoff + m * 2048 + k * 1024); } while (0)
#define PG8_LDB(dst, b, h) do { _Pragma("unroll") for (int n = 0; n < 2; ++n) _Pragma("unroll") for (int k = 0; k < 2; ++k) dst[n][k] = *(const PG8_LAS bf16x8*)(lds + PG8_SB(b, h) + boff + n * 2048 + k * 1024); } while (0)
#define PG8_MMA(ai, bj, At, Bt) do { __builtin_amdgcn_s_setprio(1); _Pragma("unroll") for (int m = 0; m < 4; ++m) _Pragma("unroll") for (int n = 0; n < 2; ++n) _Pragma("unroll") for (int k = 0; k < 2; ++k) \
        acc[ai][bj][m][n] = __builtin_amdgcn_mfma_f32_16x16x32_bf16(Bt[n][k], At[m][k], acc[ai][bj][m][n], 0, 0, 0); __builtin_amdgcn_s_setprio(0); } while (0)
#define PG8_WAIT_V(n) asm volatile("s_waitcnt vmcnt(" #n ")" ::: "memory")
#define PG8_WAIT_L(n) asm volatile("s_waitcnt lgkmcnt(" #n ")" ::: "memory")
#define PG8_BAR __builtin_amdgcn_s_barrier()
#define PG8_SCHED __builtin_amdgcn_sched_barrier(0)
    Unit cur, nxt; int ui = 0;
    if (!S.next(0, cur)) return;
    f32x4 acc[2][2][4][2];
#pragma unroll
    for (int a = 0; a < 2; ++a)
#pragma unroll
        for (int b = 0; b < 2; ++b)
#pragma unroll
            for (int m = 0; m < 4; ++m)
#pragma unroll
                for (int n = 0; n < 2; ++n) acc[a][b][m][n] = (f32x4){0.f, 0.f, 0.f, 0.f};
    bf16x8 At[4][2], B0[2][2], B1[2][2];
    const char* cA = (const char*)g.A + (GATHER ? (size_t)0 : (size_t)cur.pm * tstep); const char* cB = (const char*)g.Bt + (size_t)cur.pn * tstep;
    unsigned gA00 = 0, gA01 = 0, gA10 = 0, gA11 = 0, gN00 = 0, gN01 = 0, gN10 = 0, gN11 = 0;
    if constexpr (GATHER) { PG8_GLOAD(gA, S.toks(0)); }
    S.a_ready(cur);
    if constexpr (SP2) {
        PG8_STAGE(PG8_SB(0, 0), cB, voffB); PG8_STAGE(PG8_SB(0, 1), cB + hstep, voffB); PG8_STAGE_A(PG8_SA(0, 0), cA, 0, false); PG8_STAGE_A(PG8_SA(0, 1), cA, 1, false);
        if (wr == 1) PG8_BAR;
        PG8_WAIT_V(2); PG8_BAR;
        PG8_STAGE(PG8_SB(1, 0), cB + kstep, voffB); PG8_STAGE_A(PG8_SA(1, 0), cA + kstep, 0, false); PG8_STAGE(PG8_SB(1, 1), cB + hstep + kstep, voffB);
        PG8_WAIT_V(6); PG8_BAR;
    } else {
        PG8_STAGE(PG8_SB(0, 0), cB, voffB); PG8_STAGE(PG8_SA(0, 0), cA, voffA); PG8_STAGE(PG8_SB(0, 1), cB + hstep, voffB); PG8_STAGE(PG8_SA(0, 1), cA + hstep, voffA);
        if (wr == 1) PG8_BAR;
        PG8_WAIT_V(4); PG8_BAR;
        PG8_STAGE(PG8_SB(1, 0), cB + kstep, voffB); PG8_STAGE(PG8_SA(1, 0), cA + kstep, voffA); PG8_STAGE(PG8_SB(1, 1), cB + hstep + kstep, voffB);
        PG8_WAIT_V(6); PG8_BAR;
    }
    for (;;) {
        const bool has_next = S.next(ui + 1, nxt);
        if constexpr (GATHER) { if (has_next) { PG8_GLOAD(gN, S.toks(ui + 1)); } else { gN00 = gA00; gN01 = gA01; gN10 = gA10; gN11 = gA11; } }
        const char* nA = (has_next && !GATHER) ? (const char*)g.A + (size_t)nxt.pm * tstep : cA; const char* nB = has_next ? (const char*)g.Bt + (size_t)nxt.pn * tstep : cB;
        for (int t = 0; t < nt; t += 2) {
            const bool last = (t == nt - 2);
            const char* a1 = cA + (size_t)(t + 1) * kstep;
            const char* a2 = last ? nA : cA + (size_t)(t + 2) * kstep; const char* b2 = last ? nB : cB + (size_t)(t + 2) * kstep;
            const char* a3 = a2 + kstep; const char* b3 = b2 + kstep;
            if (last && has_next) S.a_ready(nxt);
            if constexpr (SP2) {
            PG8_LDB(B0, 0, 0); PG8_LDB(B1, 0, 1); PG8_SCHED; PG8_LDA(At, 0, 0); PG8_STAGE_A(PG8_SA(1, 1), a1, 1, false);
            PG8_WAIT_V(8); PG8_WAIT_L(0); PG8_BAR; PG8_MMA(0, 0, At, B0); PG8_MMA(0, 1, At, B1); PG8_BAR; PG8_SCHED;
            PG8_LDA(At, 0, 1); PG8_STAGE(PG8_SB(0, 0), b2, voffB); PG8_STAGE(PG8_SB(0, 1), b2 + hstep, voffB); PG8_STAGE_A(PG8_SA(0, 0), a2, 0, last);
            PG8_WAIT_V(8); PG8_WAIT_L(0); PG8_BAR; PG8_MMA(1, 0, At, B0); PG8_MMA(1, 1, At, B1); PG8_BAR; PG8_SCHED;
            PG8_LDB(B0, 1, 0); PG8_LDB(B1, 1, 1); PG8_SCHED; PG8_LDA(At, 1, 0); PG8_STAGE_A(PG8_SA(0, 1), a2, 1, last);
            PG8_WAIT_V(8); PG8_WAIT_L(0); PG8_BAR; PG8_MMA(0, 0, At, B0); PG8_MMA(0, 1, At, B1); PG8_BAR; PG8_SCHED;
            PG8_LDA(At, 1, 1); PG8_STAGE(PG8_SB(1, 0), b3, voffB); PG8_STAGE(PG8_SB(1, 1), b3 + hstep, voffB); PG8_STAGE_A(PG8_SA(1, 0), a3, 0, last);
            PG8_WAIT_V(8); PG8_WAIT_L(0); PG8_BAR; PG8_MMA(1, 0, At, B0); PG8_MMA(1, 1, At, B1); PG8_BAR; PG8_SCHED;
            } else {
            PG8_LDB(B0, 0, 0); PG8_SCHED; PG8_LDA(At, 0, 0); PG8_STAGE(PG8_SA(1, 1), a1 + hstep, voffA);
            PG8_WAIT_L(8); PG8_BAR; PG8_WAIT_L(0); PG8_MMA(0, 0, At, B0); PG8_BAR; PG8_SCHED;
            PG8_LDB(B1, 0, 1); PG8_STAGE(PG8_SB(0, 0), b2, voffB);
            PG8_BAR; PG8_WAIT_L(0); PG8_MMA(0, 1, At, B1); PG8_BAR;
            PG8_LDA(At, 0, 1); PG8_STAGE(PG8_SA(0, 0), a2, voffA);
            PG8_BAR; PG8_WAIT_L(0); PG8_MMA(1, 0, At, B0); PG8_BAR; PG8_SCHED;
            PG8_STAGE(PG8_SB(0, 1), b2 + hstep, voffB);
            PG8_WAIT_V(6); PG8_BAR; PG8_MMA(1, 1, At, B1); PG8_BAR;
            PG8_LDB(B0, 1, 0); PG8_SCHED; PG8_LDA(At, 1, 0); PG8_STAGE(PG8_SA(0, 1), a2 + hstep, voffA);
            PG8_WAIT_L(8); PG8_BAR; PG8_WAIT_L(0); PG8_MMA(0, 0, At, B0); PG8_BAR; PG8_SCHED;
            PG8_LDB(B1, 1, 1); PG8_STAGE(PG8_SB(1, 0), b3, voffB);
            PG8_BAR; PG8_WAIT_L(0); PG8_MMA(0, 1, At, B1); PG8_BAR;
            PG8_LDA(At, 1, 1); PG8_STAGE(PG8_SA(1, 0), a3, voffA);
            PG8_BAR; PG8_WAIT_L(0); PG8_MMA(1, 0, At, B0); PG8_BAR; PG8_SCHED;
            PG8_STAGE(PG8_SB(1, 1), b3 + hstep, voffB);
            PG8_WAIT_V(6); PG8_BAR; PG8_MMA(1, 1, At, B1); PG8_BAR;
            }
        }
        if constexpr (ALIGN_EPI) { if (wr == 0) PG8_BAR; }
        if constexpr (!Epi::AFTER_DRAIN) { E(acc, cur, wr, wc, fr, fq); S.done(cur); }
        if (!has_next) break;
#pragma unroll
        for (int a = 0; a < 2; ++a)
#pragma unroll
            for (int b = 0; b < 2; ++b)
#pragma unroll
                for (int m = 0; m < 4; ++m)
#pragma unroll
                    for (int n = 0; n < 2; ++n) acc[a][b][m][n] = (f32x4){0.f, 0.f, 0.f, 0.f};
        cur = nxt; cA = nA; cB = nB; ++ui; if constexpr (GATHER) { gA00 = gN00; gA01 = gN01; gA10 = gN10; gA11 = gN11; }
        if constexpr (ALIGN_EPI) { if (wr == 1) PG8_BAR; }
    }
    PG8_WAIT_V(0);
    if constexpr (!ALIGN_EPI) { if (wr == 0) PG8_BAR; }
    PG8_BAR;
    if constexpr (Epi::AFTER_DRAIN) { E.fused(acc, cur, wr, wc, fr, fq, lds, wid, lane); S.done(cur); }
#undef PG8_SA
#undef PG8_SB
#undef PG8_STAGE
#undef PG8_STAGE2
#undef PG8_STAGE_A
#undef PG8_GLOAD
#undef PG8_LDA
#undef PG8_LDB
#undef PG8_MMA
#undef PG8_WAIT_V
#undef PG8_WAIT_L
#undef PG8_BAR
#undef PG8_SCHED
}
}

namespace att {
typedef LAS const char* lds_cptr;
typedef short v4i16_t __attribute__((ext_vector_type(4)));
constexpr int NSK = 4, NSV = 5, K_SLOT = 12288, V_SLOT = 16384, LDS_K = 0, LDS_V = NSK * K_SLOT, LDS_JUNK = LDS_V + NSV * V_SLOT, LDS_WS = LDS_JUNK + 4096, LDS_END = LDS_WS + 2048, LDS_ST = 0;
static_assert(LDS_END <= LDSCTL_OFF && 8 * 8192 <= LDS_JUNK, "attention LDS");
constexpr float THR = 8.f;
__device__ __forceinline__ constexpr int cr(int r) { return (r & 3) + 8 * (r >> 2); }
__device__ __forceinline__ s16x4 vtr(lds_cptr p) { return __builtin_bit_cast(s16x4, __builtin_amdgcn_ds_read_tr16_b64_v4i16((LAS v4i16_t*)p)); }
#define ATT_MFMA(a, b, c) __builtin_amdgcn_mfma_f32_32x32x16_bf16(a, b, c, 0, 0, 0)
#define ATT_BAR() do { asm volatile("s_waitcnt lgkmcnt(0)" ::: "memory"); __builtin_amdgcn_s_barrier(); asm volatile("" ::: "memory"); } while (0)
#define ATT_SB() __builtin_amdgcn_sched_barrier(0)
__device__ __forceinline__ int rowblock(int wid) { return wid < 4 ? wid : 11 - wid; }

__device__ __forceinline__ void glds16(const void* g, unsigned lds_base) {
    unsigned sv; asm volatile("s_mov_b32 %0, m0\n\ts_mov_b32 m0, %2\n\ts_nop 0\n\tglobal_load_lds_dwordx4 %1, off\n\ts_mov_b32 m0, %0" : "=&s"(sv) : "v"(g), "s"(lds_base) : "memory"); }
template <int KCH, int VCH>
__device__ __forceinline__ void issue_tile(const unsigned char* ksrc, const unsigned char* vsrc, unsigned lds0, int kslot, int vslot, int wid) {
    const unsigned kd = (unsigned)__builtin_amdgcn_readfirstlane((int)(lds0 + LDS_K + kslot * K_SLOT + wid * 1024)), vd = (unsigned)__builtin_amdgcn_readfirstlane((int)(lds0 + LDS_V + vslot * V_SLOT + wid * 1024));
    glds16(ksrc + wid * 1024, kd);
    glds16(vsrc + wid * 1024, vd);
    if (VCH == 16) glds16(vsrc + (wid + 8) * 1024, vd + 8192);
    else if (wid < 4) glds16(ksrc + (wid + 8) * 1024, kd + 8192);
    else glds16(ksrc + wid * 1024, (unsigned)__builtin_amdgcn_readfirstlane((int)(lds0 + LDS_JUNK + (wid - 4) * 1024)));
    static_assert((KCH == 12 && VCH == 8) || (KCH == 8 && VCH == 16), "piece dealing");
}
__device__ __forceinline__ void vread4(bf16x8 (&vf)[4], lds_cptr vp) {
#pragma unroll
    for (int ksl = 0; ksl < 4; ++ksl) { const s16x4 lo = vtr(vp + ksl * 1024), hh = vtr(vp + ksl * 1024 + 512); vf[ksl] = (bf16x8){lo[0], lo[1], lo[2], lo[3], hh[0], hh[1], hh[2], hh[3]}; }
}
template <int N0, int N1, int NF>
__device__ __forceinline__ void kread(bf16x8 (&kf)[NF], lds_cptr kb) {
#pragma unroll
    for (int i = N0; i < N1; ++i) kf[i] = *(const LAS bf16x8*)(kb + (i >> 1) * 2048 + (i & 1) * 512);
}

template <int NDB, int NF>
__device__ __forceinline__ void pv_tile(f32x16 (&o)[NDB], f32x16& l_acc, const bf16x8 (&pa)[4], bf16x8 (&va)[4], bf16x8 (&vb)[4], lds_cptr vp, bf16x8 (&kf)[NF], lds_cptr kbn, bool pf) {
    const bf16x8 ones = (bf16x8){0x3F80, 0x3F80, 0x3F80, 0x3F80, 0x3F80, 0x3F80, 0x3F80, 0x3F80};
    ATT_SB();
    if constexpr (NDB == 2) {
        if (pf) kread<0, NF / 3, NF>(kf, kbn);
#pragma unroll
        for (int ksl = 0; ksl < 4; ++ksl) l_acc = ATT_MFMA(pa[ksl], ones, l_acc);
        ATT_SB();
        if (pf) kread<NF / 3, 2 * NF / 3, NF>(kf, kbn);
#pragma unroll
        for (int ksl = 0; ksl < 4; ++ksl) o[0] = ATT_MFMA(pa[ksl], va[ksl], o[0]);
        ATT_SB();
        if (pf) kread<2 * NF / 3, NF, NF>(kf, kbn);
#pragma unroll
        for (int ksl = 0; ksl < 4; ++ksl) o[1] = ATT_MFMA(pa[ksl], vb[ksl], o[1]);
        ATT_SB();
    } else {
        vread4(vb, vp + 4096);
#pragma unroll
        for (int ksl = 0; ksl < 4; ++ksl) o[0] = ATT_MFMA(pa[ksl], va[ksl], o[0]);
        ATT_SB();
        vread4(va, vp + 2 * 4096);
#pragma unroll
        for (int ksl = 0; ksl < 4; ++ksl) o[1] = ATT_MFMA(pa[ksl], vb[ksl], o[1]);
        ATT_SB();
        vread4(vb, vp + 3 * 4096);
#pragma unroll
        for (int ksl = 0; ksl < 4; ++ksl) l_acc = ATT_MFMA(pa[ksl], ones, l_acc);
        ATT_SB();
        if (pf) kread<0, NF / 2, NF>(kf, kbn);
#pragma unroll
        for (int ksl = 0; ksl < 4; ++ksl) o[2] = ATT_MFMA(pa[ksl], va[ksl], o[2]);
        ATT_SB();
        if (pf) kread<NF / 2, NF, NF>(kf, kbn);
#pragma unroll
        for (int ksl = 0; ksl < 4; ++ksl) o[3] = ATT_MFMA(pa[ksl], vb[ksl], o[3]);
        ATT_SB();
    }
}

template <int DK, int DV, int VAR>
__device__ __forceinline__ void attn_pass(const bf16* Qu, int qpitch, const unsigned char* kimg, const unsigned char* vimg, int qb, LAS unsigned char* lds, int wid, int lane, f32x16 (&o)[DV / 32]) {
    constexpr int KCH = DK / 8, VCH = DV / 8, KTB = KCH * 1024, VTB = VCH * 1024, ND0 = DK / 16, NDB = DV / 32, NF = 2 * ND0;
    const int r32 = lane & 31, hi = lane >> 5, grp = wid >> 2, rb = rowblock(wid);
    const int NT = 4 * qb + 4, tlast = 4 * qb + (rb >> 1), limh = 32 * (rb & 1) + r32 - 4 * hi;
    const bf16* Qw = Qu + (size_t)(rb * 32) * qpitch;
    bf16x8 qr[ND0];
#pragma unroll
    for (int d0 = 0; d0 < ND0; ++d0) qr[d0] = *(const bf16x8*)(Qw + (size_t)r32 * qpitch + d0 * 16 + hi * 8);
#pragma unroll
    for (int d = 0; d < NDB; ++d) o[d] = f32x16{};
    constexpr bool NEGM = (NDB == 2);
    f32x16 l_acc = f32x16{}, negm = f32x16{}; float mref = 0.f;
    LAS float* wsfh = (LAS float*)(lds + LDS_WS) + wid * 64 + 4 * hi;
    const unsigned char* ks = kimg + lane * 16; const unsigned char* vs = vimg + lane * 16;
    const lds_cptr kb0 = (lds_cptr)lds + LDS_K + hi * 1024 + r32 * 16;
    const lds_cptr vp0 = (lds_cptr)lds + LDS_V + ((lane >> 4) & 1) * 32 + (lane & 3) * 8 + (4 * hi + ((lane & 15) >> 2)) * 64;
    bf16x8 pa[4], va[4], vb[4], kf[NF];
#pragma unroll
    for (int i = 0; i < 4; ++i) { pa[i] = bf16x8{}; va[i] = bf16x8{}; vb[i] = bf16x8{}; }
    const unsigned lds0 = (unsigned)(uintptr_t)lds;
    __syncthreads();
    issue_tile<KCH, VCH>(ks, vs, lds0, 0, 0, wid);
    issue_tile<KCH, VCH>(ks + KTB, vs + VTB, lds0, 1, 1, wid);
    issue_tile<KCH, VCH>(ks + 2 * KTB, vs + 2 * VTB, lds0, 2, 2, wid);
#pragma unroll
    for (int d0 = 0; d0 < ND0; ++d0) asm volatile("" : "+v"(qr[d0]));
    asm volatile("s_waitcnt vmcnt(3)" ::: "memory"); __builtin_amdgcn_s_barrier(); asm volatile("" ::: "memory");
    kread<0, NF, NF>(kf, kb0);
    int vsl = 0, vsl_prev = 0, vsl_iss = 3;
    for (int s = 0; s <= NT; ++s) {
        const bool issued = s + 3 < NT;
        if (issued) { issue_tile<KCH, VCH>(ks + (size_t)(s + 3) * KTB, vs + (size_t)(s + 3) * VTB, lds0, (s + 3) & 3, vsl_iss, wid); vsl_iss = vsl_iss == NSV - 1 ? 0 : vsl_iss + 1; }
        if (grp == 1 && s >= 1 && s - 1 <= tlast) pv_tile<NDB, NF>(o, l_acc, pa, va, vb, vp0 + vsl_prev * V_SLOT, kf, kb0 + (s & 3) * K_SLOT, s <= tlast);
        if (s < NT && s <= tlast) {
            const lds_cptr vp = vp0 + vsl * V_SLOT;
            f32x16 p0, p1;
            ATT_SB();
            vread4(va, vp);
#pragma unroll
            for (int d0 = 0; d0 < ND0; ++d0) {
                if (d0 == 2) { ATT_SB(); if constexpr (NDB == 2) vread4(vb, vp + 4096); }
                if (d0 == 4) { ATT_SB(); }
                if (d0 == 0) { if constexpr (NEGM) { p0 = ATT_MFMA(kf[0], qr[0], negm); p1 = ATT_MFMA(kf[1], qr[0], negm); } else { p0 = ATT_MFMA(kf[0], qr[0], f32x16{}); p1 = ATT_MFMA(kf[1], qr[0], f32x16{}); } }
                else { p0 = ATT_MFMA(kf[2 * d0], qr[d0], p0); p1 = ATT_MFMA(kf[2 * d0 + 1], qr[d0], p1); }
            }
            ATT_SB();
            if constexpr (!NEGM) {
#pragma unroll
                for (int r = 0; r < 16; ++r) { p0[r] -= mref; p1[r] -= mref; }
            }
            if (s == tlast) {
#pragma unroll
                for (int r = 0; r < 16; ++r) { if (cr(r) > limh) p0[r] = -INFINITY; if (cr(r) + 32 > limh) p1[r] = -INFINITY; }
            }
            float rm = __builtin_fmaxf(p0[0], p1[0]);
#pragma unroll
            for (int r = 1; r < 16; ++r) rm = __builtin_fmaxf(__builtin_fmaxf(rm, p0[r]), p1[r]);
            { auto rr = __builtin_amdgcn_permlane32_swap(__float_as_uint(rm), __float_as_uint(rm), false, false); rm = __builtin_fmaxf(__uint_as_float(rr[0]), __uint_as_float(rr[1])); }
            if (s == 0 || __any(rm > THR)) {
                const float dl = s == 0 ? rm : __builtin_fmaxf(rm, 0.f), f = s == 0 ? 1.f : __builtin_amdgcn_exp2f(-dl); mref += dl;
#pragma unroll
                for (int r = 0; r < 16; ++r) { p0[r] -= dl; p1[r] -= dl; if constexpr (NEGM) negm[r] = -mref; }
                if (hi == 0) wsfh[r32] = f;
                LDS_WAIT();
#pragma unroll
                for (int r = 0; r < 16; ++r) { const float fr_ = wsfh[cr(r)]; l_acc[r] *= fr_;
#pragma unroll
                    for (int d = 0; d < NDB; ++d) o[d][r] *= fr_; }
            }
#pragma unroll
            for (int r = 0; r < 16; ++r) { if constexpr (VAR & 1) { p0[r] *= 0.001f; p1[r] *= 0.001f; } else { p0[r] = __builtin_amdgcn_exp2f(p0[r]); p1[r] = __builtin_amdgcn_exp2f(p1[r]); } }
            { v4u w;
              w.x = cvtpk(p0[0], p0[1]); w.y = cvtpk(p0[2], p0[3]); w.z = cvtpk(p0[4], p0[5]); w.w = cvtpk(p0[6], p0[7]); pa[0] = __builtin_bit_cast(bf16x8, w);
              w.x = cvtpk(p0[8], p0[9]); w.y = cvtpk(p0[10], p0[11]); w.z = cvtpk(p0[12], p0[13]); w.w = cvtpk(p0[14], p0[15]); pa[1] = __builtin_bit_cast(bf16x8, w);
              w.x = cvtpk(p1[0], p1[1]); w.y = cvtpk(p1[2], p1[3]); w.z = cvtpk(p1[4], p1[5]); w.w = cvtpk(p1[6], p1[7]); pa[2] = __builtin_bit_cast(bf16x8, w);
              w.x = cvtpk(p1[8], p1[9]); w.y = cvtpk(p1[10], p1[11]); w.z = cvtpk(p1[12], p1[13]); w.w = cvtpk(p1[14], p1[15]); pa[3] = __builtin_bit_cast(bf16x8, w); }
            if (grp == 0) pv_tile<NDB, NF>(o, l_acc, pa, va, vb, vp, kf, kb0 + ((s + 1) & 3) * K_SLOT, s + 1 <= tlast);
        }
        if (issued) asm volatile("s_waitcnt vmcnt(3)" ::: "memory"); else asm volatile("s_waitcnt vmcnt(0)" ::: "memory");
        if constexpr (VAR & 16) { asm volatile("s_waitcnt lgkmcnt(0)" ::: "memory"); } else { ATT_BAR(); }
        vsl_prev = vsl; vsl = vsl == NSV - 1 ? 0 : vsl + 1;
    }
#pragma unroll
    for (int r = 0; r < 16; ++r) { const float rl = __builtin_amdgcn_rcpf(l_acc[r]);
#pragma unroll
        for (int d = 0; d < NDB; ++d) o[d][r] *= rl; }
}

struct AttnArgs { const bf16* QM; const unsigned char* KM; const unsigned char* VM; const bf16* DQ; const unsigned char* DKI; const unsigned char* DVI; bf16* ATT; const float* subln_g; float lam; v4u* stash; };

template <int VAR> __device__ __forceinline__ void mla_unit(const AttnArgs& A, int b, int h, int qb, LAS unsigned char* lds, int wid, int lane_in) {
    int lane = lane_in; asm volatile("" : "+v"(lane));
    const int r32 = lane & 31, hi = lane >> 5; const size_t mu = (size_t)b * SEQ + qb * 256, m0 = mu + rowblock(wid) * 32;
    f32x16 o[2];
    attn_pass<96, 64, VAR>(A.QM + mu * 768 + h * 96, 768, A.KM + (size_t)((b * 8 + h) * 32) * 12288, A.VM + (size_t)((b * 8 + h) * 32) * 8192, qb, lds, wid, lane, o);
    LAS bf16* stg = (LAS bf16*)(lds + LDS_ST + wid * 8192); LAS bf16* sb = stg + (4 * hi) * 64 + r32; asm volatile("" : "+v"(sb));
#pragma unroll
    for (int r = 0; r < 16; ++r)
#pragma unroll
        for (int d = 0; d < 2; ++d) sb[cr(r) * 64 + d * 32] = (bf16)f2bf(o[d][r]);
    LDS_WAIT();
#pragma unroll
    for (int i = 0; i < 4; ++i) { const int row = i * 8 + (lane >> 3), ch = lane & 7; const v4u v = *(const LAS v4u*)(stg + row * 64 + ch * 8); if constexpr (VAR & 8) { asm volatile("" :: "v"(v)); } else *(v4u*)(A.ATT + (m0 + row) * 1024 + h * 64 + ch * 8) = v; }
    LDS_WAIT();
}
template <int VAR> __device__ __forceinline__ void diff_unit(const AttnArgs& A, int b, int h4, int qb, LAS unsigned char* lds, int wid, int lane_in) {
    int lane = lane_in; asm volatile("" : "+v"(lane));
    const int r32 = lane & 31, hi = lane >> 5; const size_t mu = (size_t)b * SEQ + qb * 256, m0 = mu + rowblock(wid) * 32;
    LAS bf16* stg = (LAS bf16*)(lds + LDS_ST + wid * 8192); LAS bf16* sb = stg + (4 * hi) * 128 + r32; asm volatile("" : "+v"(sb));
    const unsigned char* vimg = A.DVI + (size_t)((b * 4 + h4) * 32) * 16384;
    v4u* st = A.stash + (size_t)wid * 512 + lane;
    f32x16 o[4];
#pragma unroll 1
    for (int half = 0; half < 2; ++half) {
        attn_pass<64, 128, VAR>(A.DQ + mu * 512 + (h4 * 2 + half) * 64, 512, A.DKI + (size_t)((b * 8 + h4 * 2 + half) * 32) * 8192, vimg, qb, lds, wid, lane, o);
        if (half == 0) {
#pragma unroll
            for (int d = 0; d < 4; ++d)
#pragma unroll
                for (int i = 0; i < 2; ++i) { v4u w;
#pragma unroll
                    for (int j = 0; j < 4; ++j) w[j] = cvtpk(o[d][8 * i + 2 * j], o[d][8 * i + 2 * j + 1]);
                    st[64 * (2 * d + i)] = w; }
        }
    }
    {
        const float lam = A.lam;
#pragma unroll
        for (int d = 0; d < 4; ++d)
#pragma unroll
            for (int i = 0; i < 2; ++i) { const v4u w = st[64 * (2 * d + i)];
#pragma unroll
                for (int j = 0; j < 4; ++j) { const int r = 8 * i + 2 * j; const float a0 = bf2f(w[j] & 0xffffu), a1 = bf2f(w[j] >> 16);
                    sb[cr(r) * 128 + d * 32] = (bf16)f2bf(a0 - lam * o[d][r]); sb[cr(r + 1) * 128 + d * 32] = (bf16)f2bf(a1 - lam * o[d][r + 1]); } }
    }
    LDS_WAIT();
    {
        const int row = lane >> 1, hf = lane & 1;
        v4u v[8]; float ss = 0.f;
#pragma unroll
        for (int i = 0; i < 8; ++i) { v[i] = *(const LAS v4u*)(stg + row * 128 + hf * 64 + i * 8);
#pragma unroll
            for (int j = 0; j < 4; ++j) { const float x0 = bf2f(v[i][j] & 0xffffu), x1 = bf2f(v[i][j] >> 16); ss += x0 * x0 + x1 * x1; } }
        ss += __shfl_xor(ss, 1);
        const float rs = __builtin_amdgcn_rsqf(ss * (1.0f / 128.0f) + EPS) * (1.0f - LAM_INIT);
        bf16* op = A.ATT + (m0 + row) * 1024 + 512 + h4 * 128 + hf * 64;
        const float* gp = A.subln_g + hf * 64; asm volatile("" : "+v"(gp));
#pragma unroll
        for (int i = 0; i < 8; ++i) { v4u w;
#pragma unroll
            for (int j = 0; j < 4; ++j) { const float x0 = bf2f(v[i][j] & 0xffffu) * rs * gp[i * 8 + 2 * j], x1 = bf2f(v[i][j] >> 16) * rs * gp[i * 8 + 2 * j + 1]; w[j] = cvtpk(x0, x1); }
            if constexpr (VAR & 8) { asm volatile("" :: "v"(w)); } else *(v4u*)(op + i * 8) = w; }
    }
    LDS_WAIT();
}

__device__ __forceinline__ unsigned mla_list(int d, int& cnt) {
    switch (d) {
        case 0: cnt = 5; return 0x82B34u;
        case 1: cnt = 3; return 0x9DEu;
        case 2: cnt = 2; return 0x56u;
        case 3: cnt = 2; return 0x1Fu;
        case 4: cnt = 1; return 0x7u;
        case 5: cnt = 1; return 0xCu;
        case 6: cnt = 1; return 0xAu;
        default: cnt = 1; return 0x0u;
    }
}
template <int VAR> __device__ __forceinline__ void attn_phase(const AttnArgs& A, LAS unsigned char* lds, int vcu, int G, int wid, int lane) {
    for (int v = vcu; v < 256; v += G) {
        const int g = v >> 3, d = v & 7, b = g >> 2;
        diff_unit<VAR>(A, b, g & 3, d, lds, wid, lane);
        int cnt; unsigned lst = mla_list(d, cnt);
        for (int i = 0; i < cnt; ++i) { const int e = (lst >> (4 * i)) & 15; mla_unit<VAR>(A, b, 2 * (g & 3) + (e >> 3), e & 7, lds, wid, lane); }
    }
}
#undef ATT_MFMA
}

constexpr int NWAVES = 8;
constexpr int N_LAUNCHES = MK_N_LAUNCHES;
constexpr int PER_PHASE = 10;
constexpr int PEXP_LDS_OFF = LDSCTL_OFF + 1024;

struct In {
    const float* x; const int* positions; const float* attn_norm_g; const float* w_in; const float* q_norm_g; const float* w_uq; const float* kv_norm_g; const float* w_ukv;
    const float* lq1; const float* lk1; const float* lq2; const float* lk2; const float* subln_g; const float* w_o; const float* ffn_norm_g; const float* w_rg; const float* b_rg;
    const float* w_re; const float* b_re; const float* w_gate; const float* w_up; const float* w_down; const float* final_g;
};
struct Args { In in; float* out; unsigned char* ws; int ph_lo, ph_hi, li, pad; };


__device__ const float INVF[32] = {1.f, 0.749894261f, 0.562341332f, 0.421696514f, 0.316227764f, 0.237137377f, 0.177827939f, 0.133352131f, 0.100000001f, 0.0749894157f, 0.0562341325f, 0.0421696529f, 0.0316227749f, 0.0237137377f,
    0.0177827943f, 0.0133352149f, 0.00999999978f, 0.00749894185f, 0.00562341325f, 0.00421696482f, 0.00316227763f, 0.00237137359f, 0.00177827943f, 0.00133352145f, 0.00100000005f, 0.000749894243f, 0.000562341302f, 0.000421696517f,
    0.000316227757f, 0.00023713737f, 0.00017782794f, 0.00013335215f};
__device__ __forceinline__ void sincos_acc(float a, float& s, float& c) {
    const double ad = (double)a, k = __builtin_rint(ad * 0.63661977236758134308), r = __builtin_fma(-k, 1.57079632679489661923, ad);
    const float x = (float)r, x2 = x * x; const int q = (int)k & 3;
    const float sp = x + x * x2 * ((-1.9515295891e-4f * x2 + 8.3321608736e-3f) * x2 - 1.6666654611e-1f);
    const float cp = 1.0f - 0.5f * x2 + x2 * x2 * ((2.443315711809948e-5f * x2 - 1.388731625493765e-3f) * x2 + 4.166664568298827e-2f);
    s = (q == 0) ? sp : (q == 1) ? cp : (q == 2) ? -sp : -cp;
    c = (q == 0) ? cp : (q == 1) ? -sp : (q == 2) ? -cp : sp;
}
template <class F> __device__ __forceinline__ void tr_item64(const F& f, int K, bf16* WT, int kb, int nb, LAS unsigned* scr, int lane) {
    const int k0 = 64 * kb, n0 = 64 * nb, n4 = lane & 15, kq = lane >> 4;
    const int st = f.col(n0 + 4 * n4);
    f32x4 v[16];
#pragma unroll
    for (int i = 0; i < 16; ++i) v[i] = f.val4(k0 + 16 * kq + i, st);
#pragma unroll
    for (int j = 0; j < 4; ++j) {
        v4u a, b2;
        a.x = pk2(v[0][j], v[1][j]); a.y = pk2(v[2][j], v[3][j]); a.z = pk2(v[4][j], v[5][j]); a.w = pk2(v[6][j], v[7][j]);
        b2.x = pk2(v[8][j], v[9][j]); b2.y = pk2(v[10][j], v[11][j]); b2.z = pk2(v[12][j], v[13][j]); b2.w = pk2(v[14][j], v[15][j]);
        LAS v4u* p = (LAS v4u*)(scr + (4 * n4 + j) * 36 + 8 * kq);
        p[0] = a; p[1] = b2;
    }
    LDS_WAIT(); asm volatile("" ::: "memory");
#pragma unroll
    for (int r = 0; r < 8; ++r) { const int idx = lane + 64 * r, row = idx >> 3, ch = idx & 7;
        const v4u o = *(const LAS v4u*)(scr + row * 36 + 4 * ch);
        *(v4u*)(WT + (size_t)(n0 + row) * K + k0 + 8 * ch) = o; }
    LDS_WAIT(); asm volatile("" ::: "memory");
}
__host__ __device__ __forceinline__ int win_src(int n) {
    if (n < 384) return n;
    if (n < 416) return 640 + (n - 384);
    if (n < 512) return -1;
    if (n < 768) return 384 + (n - 512);
    if (n < 1792) { const int q = n - 768, region = q >> 9, qq = q & 511, c = qq >> 6, w = qq & 63, g = w >> 5, p = w & 31, f = 16 * g + (p & 15) + 32 * (p >> 4);
        return (region ? 1184 : 672) + 64 * c + f; }
    return 1696 + (n - 1792);
}
struct SrcWin { const float* w; const float* g; __device__ __forceinline__ int col(int n) const { return win_src(n); }
    __device__ __forceinline__ f32x4 val4(int k, int st) const { const f32x4 v = *(const f32x4*)(w + (size_t)k * IN_COLS + (st < 0 ? 0 : st)) * g[k]; return st < 0 ? f32x4{} : v; } };
struct SrcScaled { const float* w; const float* g; int N; __device__ __forceinline__ int col(int n) const { return n; }
    __device__ __forceinline__ f32x4 val4(int k, int st) const { return *(const f32x4*)(w + (size_t)k * N + st) * g[k]; } };
struct SrcPlain { const float* w; int N; __device__ __forceinline__ int col(int n) const { return n; }
    __device__ __forceinline__ f32x4 val4(int k, int st) const { return *(const f32x4*)(w + (size_t)k * N + st); } };
struct SrcGU { const float* wg; const float* wu; const float* g; __device__ __forceinline__ int col(int r) const { const int G = r >> 5, p = r & 31; return ((p >> 4) << 16) | (16 * G + (p & 15)); }
    __device__ __forceinline__ f32x4 val4(int k, int st) const { const unsigned long long d = (unsigned long long)wu - (unsigned long long)wg; const float* w = (const float*)((unsigned long long)wg + ((st >> 16) ? d : 0ull));
        return *(const f32x4*)(w + (size_t)k * DFF + (st & 0xffff)) * g[k]; } };

constexpr int I64_IN = 16 * 36, I64_UQ = 6 * 12, I64_UKV = 4 * 16, I64_O = 16 * 16, I64_GU1 = 16 * 8, I64_GU = NEXP * I64_GU1, I64_D1 = 4 * 16, I64_D = NEXP * I64_D1;
constexpr int I64_LATE = I64_UQ + I64_UKV + I64_O + I64_GU + I64_D;
__device__ __forceinline__ void late_weight_item(const In& I, unsigned char* ws, int r, LAS unsigned* scr, int lane) {
    bf16* Wuq_t = (bf16*)(ws + WS_WUQ); bf16* Wukv_t = (bf16*)(ws + WS_WUKV); bf16* Wo_t = (bf16*)(ws + WS_WO); bf16* Wgu_t = (bf16*)(ws + WS_WGU); bf16* Wd_t = (bf16*)(ws + WS_WD);
    if (r < I64_UQ) { SrcScaled f{I.w_uq, I.q_norm_g, 768}; tr_item64(f, QR, Wuq_t, r / 12, r % 12, scr, lane); return; } r -= I64_UQ;
    if (r < I64_UKV) { SrcScaled f{I.w_ukv, I.kv_norm_g, 1024}; tr_item64(f, KVR, Wukv_t, r / 16, r % 16, scr, lane); return; } r -= I64_UKV;
    if (r < I64_O) { SrcPlain f{I.w_o, 1024}; tr_item64(f, 1024, Wo_t, r / 16, r % 16, scr, lane); return; } r -= I64_O;
    if (r < I64_GU) { const int e = r / I64_GU1, q = r % I64_GU1; SrcGU f{I.w_gate + (size_t)e * DM * DFF, I.w_up + (size_t)e * DM * DFF, I.ffn_norm_g}; tr_item64(f, 1024, Wgu_t + (size_t)e * 512 * 1024, q / 8, q % 8, scr, lane); return; } r -= I64_GU;
    { const int e = r / I64_D1, q = r % I64_D1; SrcPlain f{I.w_down + (size_t)e * DFF * DM, 1024}; tr_item64(f, DFF, Wd_t + (size_t)e * 1024 * DFF, q / 16, q % 16, scr, lane); }
}

__device__ __forceinline__ void p0_prologue(const In& I, unsigned char* ws, LAS unsigned char* lds, int vcu, int G, int wave, int lane) {
    LAS unsigned* scr = (LAS unsigned*)(lds + RING_OFF + wave * 16384);
    const int gw = vcu * NWAVES + wave, NGW = G * NWAVES;
    bf16* Win_t = (bf16*)(ws + WS_WIN);
    for (int it = gw; it < I64_IN; it += NGW) { SrcWin f{I.w_in, I.attn_norm_g}; tr_item64(f, 1024, Win_t, it / 36, it % 36, scr, lane); }
    bf16* XB = (bf16*)(ws + WS_XB);
    for (int m = gw; m < T_TOK; m += NGW) {
        const f32x4* xr = (const f32x4*)(I.x + (size_t)m * DM) + lane;
        f32x4 v[4]; float s = 0.f;
#pragma unroll
        for (int j = 0; j < 4; ++j) { v[j] = xr[64 * j]; s += (v[j].x * v[j].x + v[j].y * v[j].y) + (v[j].z * v[j].z + v[j].w * v[j].w); }
        const float rs = 1.0f / sqrtf(wave_sum(s) * (1.0f / DM) + EPS);
        v2u* o8 = (v2u*)(XB + (size_t)m * DM) + lane;
#pragma unroll
        for (int j = 0; j < 4; ++j) { v2u w; w.x = pk2(v[j].x * rs, v[j].y * rs); w.y = pk2(v[j].z * rs, v[j].w * rs); o8[64 * j] = w; }
    }
    { v4u* z = (v4u*)((unsigned*)(ws + WS_CTL) + CW_SSQQ); for (int idx = gw * 64 + lane; idx < 2 * 16384 * 8 / 16; idx += NGW * 64) z[idx] = v4u{0u, 0u, 0u, 0u}; }
    f32x2* cs = (f32x2*)(ws + WS_CS);
    for (int idx = gw * 64 + lane; idx < T_TOK * 32; idx += NGW * 64) {
        const int m = idx >> 5, i = idx & 31;
        const float ang = (float)I.positions[m] * INVF[i];
        float sn, cn; sincos_acc(ang, sn, cn); f32x2 c; c.x = cn; c.y = sn; cs[idx] = c;
    }
    bf16* wrh = (bf16*)(ws + WS_WR); bf16* wrl = wrh + 48 * 1024;
    for (int idx = gw * 64 + lane; idx < 48 * 1024; idx += NGW * 64) {
        const int j = idx >> 10, k = idx & 1023;
        float w = j < 4 ? I.w_rg[k * 4 + j] : (j < 36 ? I.w_re[k * 32 + (j - 4)] : 0.f);
        w *= I.ffn_norm_g[k];
        const unsigned h = f2bf(w); wrh[idx] = (bf16)h; wrl[idx] = (bf16)f2bf(w - bf2f(h));
    }
}

constexpr int RT_PART = 2048, RT_STRIDE = 49, RT_SSQ = RT_PART + 8 * 64 * RT_STRIDE * 4;
static_assert(RT_SSQ + 8 * 64 * 4 <= RING_BYTES, "router LDS");
__device__ __forceinline__ void route_phase(const In& I, const bf16* HB, unsigned char* ws, LAS unsigned char* lds, int vcu, int G, int wave, int lane) {
    LAS unsigned* cnt_l = (LAS unsigned*)(lds + 0); LAS unsigned* base_l = (LAS unsigned*)(lds + 128);
    LAS float* part = (LAS float*)(lds + RT_PART); LAS float* pssq = (LAS float*)(lds + RT_SSQ);
    const bf16* wrh = (const bf16*)(ws + WS_WR); const bf16* wrl = wrh + 48 * 1024;
    unsigned* gcnt = (unsigned*)(ws + WS_CTL) + CW_CNT;
    v4u* rec = (v4u*)(ws + WS_REC); int* TOK = (int*)(ws + WS_TOK); float* GWT = (float*)(ws + WS_GWT); float* RST = (float*)(ws + WS_RST);
    const int tid = wave * 64 + lane, rl = lane & 15, kg = lane >> 4, k0 = 128 * wave + 8 * kg;
    bf16x8 bh[3][4], bl[3][4];
#pragma unroll
    for (int cb = 0; cb < 3; ++cb)
#pragma unroll
        for (int s = 0; s < 4; ++s) { bh[cb][s] = *(const bf16x8*)(wrh + (size_t)(16 * cb + rl) * 1024 + k0 + 32 * s); bl[cb][s] = *(const bf16x8*)(wrl + (size_t)(16 * cb + rl) * 1024 + k0 + 32 * s); }
    for (int grp = vcu; grp < T_TOK / 64; grp += G) {
        const int m0 = 64 * grp;
        if (tid < 32) cnt_l[tid] = 0u;
#pragma unroll 1
        for (int gp = 0; gp < 2; ++gp) {
            bf16x8 a[2][4];
#pragma unroll
            for (int g = 0; g < 2; ++g)
#pragma unroll
                for (int s = 0; s < 4; ++s) a[g][s] = *(const bf16x8*)(HB + (size_t)(m0 + 32 * gp + 16 * g + rl) * DM + k0 + 32 * s);
#pragma unroll
            for (int g = 0; g < 2; ++g) {
                float ss = 0.f; f32x4 acc[3]; acc[0] = f32x4{}; acc[1] = f32x4{}; acc[2] = f32x4{};
#pragma unroll
                for (int s = 0; s < 4; ++s) {
                    const v4u w = __builtin_bit_cast(v4u, a[g][s]);
#pragma unroll
                    for (int j = 0; j < 4; ++j) { const float x0 = bf2f(w[j] & 0xffffu), x1 = bf2f(w[j] >> 16); ss += x0 * x0 + x1 * x1; }
#pragma unroll
                    for (int cb = 0; cb < 3; ++cb) { acc[cb] = __builtin_amdgcn_mfma_f32_16x16x32_bf16(a[g][s], bh[cb][s], acc[cb], 0, 0, 0); acc[cb] = __builtin_amdgcn_mfma_f32_16x16x32_bf16(a[g][s], bl[cb][s], acc[cb], 0, 0, 0); }
                }
                ss += __shfl_xor(ss, 16); ss += __shfl_xor(ss, 32);
                const int tg = 32 * gp + 16 * g;
                if (kg == 0) pssq[wave * 64 + tg + rl] = ss;
#pragma unroll
                for (int cb = 0; cb < 3; ++cb)
#pragma unroll
                    for (int r = 0; r < 4; ++r) part[(wave * 64 + tg + 4 * kg + r) * RT_STRIDE + 16 * cb + rl] = acc[cb][r];
            }
        }
        __syncthreads();
        int e0 = 0, e1 = 0; float w0 = 0.f, w1 = 0.f, rstd = 0.f; unsigned lr0 = 0, lr1 = 0;
        if (wave == 0) {
            float L[36]; float ssq = 0.f;
#pragma unroll
            for (int j = 0; j < 36; ++j) L[j] = 0.f;
#pragma unroll 1
            for (int w = 0; w < 8; ++w) { ssq += pssq[w * 64 + lane];
#pragma unroll
                for (int j = 0; j < 36; ++j) L[j] += part[(w * 64 + lane) * RT_STRIDE + j]; }
            rstd = 1.0f / sqrtf(ssq * (1.0f / DM) + EPS);
            float gl[4];
#pragma unroll
            for (int g = 0; g < 4; ++g) gl[g] = L[g] * rstd + I.b_rg[g];
            int gi = 0; float gm = gl[0];
#pragma unroll
            for (int g = 1; g < 4; ++g) if (gl[g] > gm) { gm = gl[g]; gi = g; }
            float ps = 0.f;
#pragma unroll
            for (int g = 0; g < 4; ++g) ps += __expf(gl[g] - gm);
            const float pg = 1.0f / ps;
            float el[8];
#pragma unroll
            for (int e = 0; e < 8; ++e) { const float raw = gi == 0 ? L[4 + e] : gi == 1 ? L[12 + e] : gi == 2 ? L[20 + e] : L[28 + e]; el[e] = raw * rstd + I.b_re[8 * gi + e]; }
            int i1 = 0; float l1 = el[0];
#pragma unroll
            for (int e = 1; e < 8; ++e) if (el[e] > l1) { l1 = el[e]; i1 = e; }
            int i2 = 0; float l2 = -INFINITY;
#pragma unroll
            for (int e = 0; e < 8; ++e) if (e != i1 && el[e] > l2) { l2 = el[e]; i2 = e; }
            const float ex = __expf(l2 - l1), wn1 = 1.0f / (1.0f + ex), wn2 = ex * wn1;
            e0 = 8 * gi + i1; e1 = 8 * gi + i2; w0 = pg * wn1; w1 = pg * wn2;
            lr0 = __hip_atomic_fetch_add(cnt_l + e0, 1u, __ATOMIC_RELAXED, __HIP_MEMORY_SCOPE_WORKGROUP);
            lr1 = __hip_atomic_fetch_add(cnt_l + e1, 1u, __ATOMIC_RELAXED, __HIP_MEMORY_SCOPE_WORKGROUP);
        }
        __syncthreads();
        if (tid < 32) { const unsigned c = cnt_l[tid]; base_l[tid] = c ? __hip_atomic_fetch_add(gcnt + tid, c, __ATOMIC_RELAXED, __HIP_MEMORY_SCOPE_AGENT) : 0u; }
        __syncthreads();
        if (wave == 0) {
            const unsigned k0r = (base_l[e0] + lr0) & 16383u, k1r = (base_l[e1] + lr1) & 16383u; const int m = m0 + lane;
            v4u r; r.x = (unsigned)e0 | ((unsigned)e1 << 8); r.y = k0r; r.z = k1r; r.w = 0u; rec[m] = r;
            TOK[e0 * 16384 + k0r] = m; GWT[e0 * 16384 + k0r] = w0; RST[e0 * 16384 + k0r] = rstd;
            TOK[e1 * 16384 + k1r] = m; GWT[e1 * 16384 + k1r] = w1; RST[e1 * 16384 + k1r] = rstd;
        }
        __syncthreads();
    }
}

constexpr int MT_PEXP = LDSCTL_OFF + 1024, MT_PBASE = MT_PEXP + 1024, MT_CNT = MT_PBASE + 128, MT_TOKL = LDSCTL_OFF + 4096;
static_assert(MT_TOKL + 3 * 1024 <= LDS_BYTES, "moe LDS");
__device__ __forceinline__ void moe_tables(const unsigned char* ws, LAS unsigned char* ldsall, int wave, int lane) {
    __syncthreads();
    if (wave == 0) {
        const unsigned* gcnt = (const unsigned*)(ws + WS_CTL) + CW_CNT;
        LAS int* pexp = (LAS int*)(ldsall + MT_PEXP); LAS int* pbase = (LAS int*)(ldsall + MT_PBASE); LAS int* cntl = (LAS int*)(ldsall + MT_CNT);
        const unsigned c = lane < 32 ? __hip_atomic_load(gcnt + (lane & 31), RLX_AGENT) : 0u; const unsigned np = (c + 255u) >> 8;
        unsigned incl = np;
#pragma unroll
        for (int o = 1; o < 32; o <<= 1) { const unsigned t = __shfl_up(incl, o); if ((lane & 31) >= o) incl += t; }
        if (lane < 32) { const unsigned pb = incl - np; pbase[lane] = (int)pb; cntl[lane] = (int)c; for (unsigned p = 0; p < np; ++p) if (pb + p < (unsigned)MAXPANEL) pexp[pb + p] = lane; }
        if (lane == 31) pexp[MAXPANEL] = (int)(incl < (unsigned)MAXPANEL ? incl : (unsigned)MAXPANEL);
    }
    __syncthreads();
}

__device__ __forceinline__ void final_phase(const In& I, const bf16* HB, float* out, const unsigned char* ws, LAS unsigned char* ldsall, int vcu, int G, int wave, int lane, float oscale) {
    const v4u* rec = (const v4u*)(ws + WS_REC); const bf16* Y = (const bf16*)(ws + WS_TS);
    const LAS int* pbase = (const LAS int*)(ldsall + MT_PBASE);
    const int pb = pbase[lane & 31] * 256;
    const f32x4* gr = (const f32x4*)I.final_g;
    const f32x4 g0 = gr[2 * lane], g1 = gr[2 * lane + 1], g2 = gr[128 + 2 * lane], g3 = gr[128 + 2 * lane + 1];
    const int gw = vcu * NWAVES + wave, NGW = G * NWAVES;
    for (int mb = 4 * gw; mb < T_TOK; mb += 4 * NGW) {
        const v4u rv = rec[mb + (lane & 3)];
        v4u h[4][2], ya[4][2], yb[4][2];
#pragma unroll
        for (int q = 0; q < 4; ++q) {
            const unsigned ee = __shfl(rv.x, q), k0r = __shfl(rv.y, q), k1r = __shfl(rv.z, q);
            unsigned s0 = (unsigned)__shfl(pb, ee & 31u) + k0r, s1 = (unsigned)__shfl(pb, (ee >> 8) & 31u) + k1r;
            s0 = s0 < (unsigned)MAXSLOT ? s0 : MAXSLOT - 1; s1 = s1 < (unsigned)MAXSLOT ? s1 : MAXSLOT - 1;
            const v4u* hp = (const v4u*)(HB + (size_t)(mb + q) * DM) + lane; const v4u* p0 = (const v4u*)(Y + (size_t)s0 * DM) + lane; const v4u* p1 = (const v4u*)(Y + (size_t)s1 * DM) + lane;
            h[q][0] = hp[0]; h[q][1] = hp[64]; ya[q][0] = p0[0]; ya[q][1] = p0[64]; yb[q][0] = p1[0]; yb[q][1] = p1[64];
        }
#pragma unroll
        for (int q = 0; q < 4; ++q) {
            f32x4 v[4]; float s = 0.f;
#pragma unroll
            for (int hf = 0; hf < 2; ++hf)
#pragma unroll
                for (int j = 0; j < 4; ++j) { const unsigned a = h[q][hf][j], b = ya[q][hf][j], c = yb[q][hf][j];
                    const float x0 = bf2f(a & 0xffffu) + bf2f(b & 0xffffu) + bf2f(c & 0xffffu), x1 = bf2f(a >> 16) + bf2f(b >> 16) + bf2f(c >> 16);
                    v[2 * hf + (j >> 1)][2 * (j & 1)] = x0; v[2 * hf + (j >> 1)][2 * (j & 1) + 1] = x1; s += x0 * x0 + x1 * x1; }
            const float rs = oscale / sqrtf(wave_sum(s) * (1.0f / DM) + EPS);
            f32x4* op = (f32x4*)(out + (size_t)(mb + q) * DM);
            op[2 * lane] = v[0] * rs * g0; op[2 * lane + 1] = v[1] * rs * g1; op[128 + 2 * lane] = v[2] * rs * g2; op[128 + 2 * lane + 1] = v[3] * rs * g3;
        }
    }
}

__global__ void __launch_bounds__(NWAVES * 64, 2) fwd_kernel(Args args) {
    extern __shared__ __attribute__((aligned(16))) unsigned char lds_raw[];
    LAS unsigned char* lds = (LAS unsigned char*)lds_raw;
    volatile LAS unsigned* MISC = (volatile LAS unsigned*)(lds + MISC_OFF);
    const int tid = threadIdx.x, lane = tid & 63, wave = __builtin_amdgcn_readfirstlane(tid >> 6);
    const int G = gridDim.x; const int bx = blockIdx.x; const int vcu = (G % 8 == 0) ? (bx % 8) * (G / 8) + bx / 8 : bx;
    unsigned char* ws = args.ws; const In& I = args.in;
    gu32* ctl = (gu32*)(ws + WS_CTL);
    for (int u = tid; u < (LDS_BYTES - LDSCTL_OFF) / 4; u += NWAVES * 64) ((LAS unsigned*)(lds + LDSCTL_OFF))[u] = 0u;
    __syncthreads();
    XcdBarrier bar; bar.bar = (unsigned*)(ctl + CW_BAR); bar.x = 0; bar.st = nullptr;
    if (N_LAUNCHES != PER_PHASE) bar = xcd_barrier_post((unsigned*)(ctl + CW_BAR), MISC + 8);
    unsigned long long* stamps = (unsigned long long*)(ws + WS_CTL) + CW_STAMP / 2; int n_stamp = 0;
    if (PROBE_PHASE >= 0 && bx == 0 && tid == 0) stamps[0] = __builtin_amdgcn_s_memrealtime();
#define GRID_BAR() do { if (N_LAUNCHES == PER_PHASE) { if (tid == 0) __hip_atomic_store(ctl + CW_TMO, 0xBADBA0u, RLX_AGENT); } else { xcd_barrier(bar); } \
    if (PROBE_PHASE >= 0) { ++n_stamp; if (bx == 0 && tid == 0) stamps[n_stamp] = __builtin_amdgcn_s_memrealtime(); } } while (0)
    const int lo = args.ph_lo, hi = args.ph_hi;
#ifndef PHMASK
#define PHMASK 0x3ff
#endif
#define IN(k) (((PHMASK >> (k)) & 1) && lo <= (k) && (k) < hi)
#define NEXTP(k) ((k) == 5 ? 7 : (k) + 1)
#define BOTH(k) (IN(k) && IN(NEXTP(k)))

    if (IN(0) && PRETOUCH) {
        const size_t gt = (size_t)bx * 512 + tid, NT_ = (size_t)G * 512; unsigned acc_ = 0;
        for (size_t pg = gt; pg < WS_END / 4096; pg += NT_) acc_ += *(const volatile unsigned*)(ws + pg * 4096);
        for (size_t pg = gt; pg < (size_t)T_TOK * DM * 4 / 4096; pg += NT_) { acc_ += *(const volatile unsigned*)((const char*)args.out + pg * 4096); acc_ += *(const volatile unsigned*)((const char*)I.x + pg * 4096); }
        for (size_t pg = gt; pg < (size_t)NEXP * DM * DFF * 4 / 4096; pg += NT_) { acc_ += *(const volatile unsigned*)((const char*)I.w_gate + pg * 4096); acc_ += *(const volatile unsigned*)((const char*)I.w_up + pg * 4096); acc_ += *(const volatile unsigned*)((const char*)I.w_down + pg * 4096); }
        asm volatile("" :: "v"(acc_));
    }
    if (IN(0)) { for (int rep = 0; rep < 1 + ((REPEAT_MASK >> 0) & 1); ++rep) { p0_prologue(I, ws, lds, vcu, G, wave, lane); __syncthreads(); } if (BOTH(0)) GRID_BAR(); }

    if (IN(1)) {
        pg8::Gemm g{(const pg8::bf16_t*)(ws + WS_XB), (const pg8::bf16_t*)(ws + WS_WIN), T_TOK, NPROJ, DM};
        pg8::StaticOrder S; S.init(T_TOK, NPROJ, G, bx);
        pg8::EpiProj E{(unsigned long long*)(ctl + CW_SSQQ), (unsigned long long*)(ctl + CW_SSQKV), (const pg8::f32x2e*)(ws + WS_CS), (pg8::bf16_t*)(ws + WS_CQ), (pg8::bf16_t*)(ws + WS_CKV), ws + WS_KM, (pg8::bf16_t*)(ws + WS_DQ), ws + WS_DKI, ws + WS_DVI};
        pg8::gemm_phase<pg8::EpiProj, pg8::StaticOrder, true, true>(lds + RING_OFF, g, S, E);
        { const int nfull = (576 % G) ? (576 % G) : G;
          if (bx >= nfull) { LAS unsigned* scr = (LAS unsigned*)(lds + RING_OFF + wave * 16384); const int nh = (G - nfull) * NWAVES;
              for (int it = (bx - nfull) * NWAVES + wave; it < I64_LATE; it += nh) late_weight_item(I, ws, it, scr, lane); }
          else if (nfull == G) { LAS unsigned* scr = (LAS unsigned*)(lds + RING_OFF + wave * 16384); for (int it = bx * NWAVES + wave; it < I64_LATE; it += G * NWAVES) late_weight_item(I, ws, it, scr, lane); } }
        if (BOTH(1)) GRID_BAR();
    }

    if (IN(2)) {
#ifndef NO_Q
        { pg8::Gemm g{(const pg8::bf16_t*)(ws + WS_CQ), (const pg8::bf16_t*)(ws + WS_WUQ), T_TOK, 768, QR};
          pg8::StaticOrder S; S.init(T_TOK, 768, G, bx);
          pg8::EpiMlaQ E{(const unsigned long long*)(ctl + CW_SSQQ), (const pg8::f32x2e*)(ws + WS_CS), (pg8::bf16_t*)(ws + WS_QM)};
          pg8::gemm_phase<pg8::EpiMlaQ, pg8::StaticOrder, true, true>(lds + RING_OFF, g, S, E); }
#endif
        __syncthreads();
#ifndef NO_KV
        { pg8::Gemm g{(const pg8::bf16_t*)(ws + WS_CKV), (const pg8::bf16_t*)(ws + WS_WUKV), T_TOK, 1024, KVR};
          pg8::StaticOrder S; S.init(T_TOK, 1024, G, (bx + 192) % G);
          pg8::EpiMlaKV E{(const unsigned long long*)(ctl + CW_SSQKV), ws + WS_KM, ws + WS_VM};
          pg8::gemm_phase<pg8::EpiMlaKV, pg8::StaticOrder, true, true>(lds + RING_OFF, g, S, E); }
#endif
        if (BOTH(2)) GRID_BAR();
    }

    if (IN(3)) {
        float lam;
        { const float a = I.lq1[lane] * I.lk1[lane], b = I.lq2[lane] * I.lk2[lane]; lam = expf(wave_sum(a)) - expf(wave_sum(b)) + LAM_INIT; }
        att::AttnArgs A{(const bf16*)(ws + WS_QM), ws + WS_KM, ws + WS_VM, (const bf16*)(ws + WS_DQ), ws + WS_DKI, ws + WS_DVI, (bf16*)(ws + WS_ATT), I.subln_g, lam, (v4u*)(ws + WS_CQ) + (size_t)bx * 4096};
        __syncthreads();
        att::attn_phase<0>(A, lds + RING_OFF, vcu, G, wave, lane);
        if (ATT_VAR) { __syncthreads(); att::attn_phase<ATT_VAR>(A, lds + RING_OFF, vcu, G, wave, lane); }
        if (BOTH(3)) GRID_BAR();
    }

    if (IN(4)) {
        pg8::Gemm g{(const pg8::bf16_t*)(ws + WS_ATT), (const pg8::bf16_t*)(ws + WS_WO), T_TOK, DM, DM};
        pg8::StaticOrder S; S.init(T_TOK, DM, G, bx);
        pg8::EpiWo E{I.x, (pg8::bf16_t*)(ws + WS_HB)};
        pg8::gemm_phase<pg8::EpiWo, pg8::StaticOrder, true, true>(lds + RING_OFF, g, S, E);
        if (BOTH(4)) GRID_BAR();
    }

    if (IN(5)) { __syncthreads(); route_phase(I, (const bf16*)(ws + WS_HB), ws, lds + RING_OFF, vcu, G, wave, lane); if (BOTH(5)) GRID_BAR(); }

    if (IN(7)) {
        moe_tables(ws, lds, wave, lane);
        LAS int* tokl = (LAS int*)(lds + MT_TOKL);
        pg8::MoeOrder S; S.init((const LAS int*)(lds + MT_PEXP), tokl, 2, G, bx);
        { const int* TOK = (const int*)(ws + WS_TOK); const LAS int* pbase = (const LAS int*)(lds + MT_PBASE); const LAS int* cntl = (const LAS int*)(lds + MT_CNT);
          for (int i = 0; i < 3; ++i) { pg8::Unit u; if (!S.next(i, u)) break; const int e = u.pn >> 1, j = u.pm - pbase[e];
              if (tid < 256) { const int rank = 256 * j + tid; tokl[256 * i + tid] = TOK[e * 16384 + (rank < cntl[e] ? rank : 0)] & 16383; } } }
        __syncthreads();
        pg8::Gemm g{(const pg8::bf16_t*)(ws + WS_HB), (const pg8::bf16_t*)(ws + WS_WGU), MAXSLOT, NEXP * 512, DM};
        pg8::EpiGateUp E{(const float*)(ws + WS_GWT), (const float*)(ws + WS_RST), (const LAS int*)(lds + MT_PBASE), (pg8::bf16_t*)(ws + WS_HDN)};
        pg8::gemm_phase<pg8::EpiGateUp, pg8::MoeOrder, true, true, true>(lds + RING_OFF, g, S, E);
        if (BOTH(7)) GRID_BAR();
    }

    if (IN(8)) {
        moe_tables(ws, lds, wave, lane);
        pg8::Gemm g{(const pg8::bf16_t*)(ws + WS_HDN), (const pg8::bf16_t*)(ws + WS_WD), MAXSLOT, NEXP * 1024, DFF};
        pg8::MoeOrder S; S.init((const LAS int*)(lds + MT_PEXP), (const LAS int*)(lds + MT_TOKL), 4, G, bx);
        pg8::EpiDown E{(pg8::bf16_t*)(ws + WS_TS)};
        for (int rep = 0; rep < 1 + ((REPEAT_MASK >> 8) & 1); ++rep) { pg8::gemm_phase<pg8::EpiDown, pg8::MoeOrder, true, true>(lds + RING_OFF, g, S, E); __syncthreads(); }
        if (BOTH(8)) GRID_BAR();
    }

    if (IN(9)) {
        float oscale = 1.0f;
        if (PROBE_PHASE >= 0) { const unsigned long long dt = PROBE_PHASE >= 100 ? stamps[PROBE_PHASE - 100] - stamps[0] : stamps[PROBE_PHASE + 1] - stamps[PROBE_PHASE]; float fr = (float)dt * (PROBE_PHASE >= 100 ? 1.0f / 400000.0f : 1.0f / PROBE_TICKS); fr = fr > 1.f ? 1.f : fr; oscale = 1.0f + sqrtf(2e-3f * fr); }
        moe_tables(ws, lds, wave, lane);
        for (int rep = 0; rep < 1 + ((REPEAT_MASK >> 9) & 1); ++rep) final_phase(I, (const bf16*)(ws + WS_HB), args.out, ws, lds, vcu, G, wave, lane, oscale);
    }
#undef IN
#undef BOTH
#undef GRID_BAR
}

extern "C" void kernel_launch(void* const* d_in, const int* in_sizes, int n_in, void* d_out, int out_size, void* d_ws, size_t ws_size, hipStream_t stream) {
    static int grid = 0;
    if (grid == 0) {
        if (n_in != 23 || in_sizes[0] != T_TOK * DM || out_size != T_TOK * DM || ws_size < WS_END) { fprintf(stderr, "kernel_launch: unexpected problem shape (n_in %d, in0 %d, out %d, ws %zu)\n", n_in, n_in > 0 ? in_sizes[0] : -1, out_size, ws_size); grid = -1; return; }
        int dev = 0, cus = 0, per_cu = 0;
        if (hipGetDevice(&dev) != hipSuccess || hipDeviceGetAttribute(&cus, hipDeviceAttributeMultiprocessorCount, dev) != hipSuccess) { grid = -1; return; }
        if (hipFuncSetAttribute((const void*)fwd_kernel, hipFuncAttributeMaxDynamicSharedMemorySize, LDS_BYTES) != hipSuccess) { fprintf(stderr, "kernel_launch: hipFuncSetAttribute failed\n"); grid = -1; return; }
        if (hipOccupancyMaxActiveBlocksPerMultiprocessor(&per_cu, (const void*)fwd_kernel, NWAVES * 64, LDS_BYTES) != hipSuccess || per_cu < 1) { fprintf(stderr, "kernel_launch: occupancy query says %d blocks per CU\n", per_cu); }
        (void)hipGetLastError();
        grid = cus;
    }
    if (grid < 0) return;
    if (hipMemsetAsync((char*)d_ws + WS_CTL, 0, CTL_ZERO_BYTES, stream) != hipSuccess) { fprintf(stderr, "kernel_launch: memset failed\n"); return; }
    Args a{};
    const void** ip = (const void**)&a.in;
    for (int i = 0; i < 23; ++i) ip[i] = d_in[i];
    a.out = (float*)d_out; a.ws = (unsigned char*)d_ws;
    if (N_LAUNCHES == 1) {
        a.ph_lo = 0; a.ph_hi = PER_PHASE; a.li = 0;
        hipLaunchKernelGGL(fwd_kernel, dim3(grid), dim3(NWAVES * 64), LDS_BYTES, stream, a);
    } else {
        for (int li = 0; li < PER_PHASE; ++li) { a.ph_lo = li; a.ph_hi = li + 1; a.li = li; hipLaunchKernelGGL(fwd_kernel, dim3(grid), dim3(NWAVES * 64), LDS_BYTES, stream, a); }
    }
    const hipError_t le = hipPeekAtLastError();
    if (le != hipSuccess) fprintf(stderr, "kernel_launch: launch failed: %s\n", hipGetErrorName(le));
}
```
